# Optimizing an MI355X kernel written in HIP

```python
import math
import jax, jax.numpy as jnp
from jax import lax
import numpy as np

D_MODEL = 2048
BATCH = 4
SEQ = 4096
DEPTH = 2

RET_HEADS = 4
RET_DK = 256
RET_DV = 256
ML_HEADS = 4
ML_DH = 256
RET_WIDTH = RET_HEADS * RET_DK
ML_WIDTH = ML_HEADS * ML_DH
CHUNK = 128
CONV_W = 4
RM_SPLITS = [RET_WIDTH * (j + 1) for j in range(4)] + [4 * RET_WIDTH + ML_WIDTH * (j + 1) for j in range(4)]
RM_COLS = 4 * RET_WIDTH + 4 * ML_WIDTH + 2 * ML_HEADS
ROPE_BASE = 10000.0
ATT_HEADS = 32
KV_HEADS = 4
HEAD_DIM = 64
WINDOW = 128
ATT_BLOCK = 128
SWA_COLS = (ATT_HEADS + 2 * KV_HEADS) * HEAD_DIM
N_BUCKETS = 32
MAX_DIST = 128
D_FF = -(-8 * D_MODEL // (3 * 256)) * 256
EPS = 1e-6

kernel_name = "hybrid_retention_mlstm_swa_sink_trunk"


def rms_norm(x, g):
    xf = x.astype(jnp.float32)
    y = xf * lax.rsqrt(jnp.mean(xf * xf, axis=-1, keepdims=True) + EPS)
    return (y * g.astype(jnp.float32)).astype(x.dtype)


def rotary(x, pos):
    d = x.shape[-1]
    inv = 1.0 / (ROPE_BASE ** jnp.linspace(0.0, 1.0, d // 2, dtype=jnp.float32))
    ang = pos.astype(jnp.float32)[:, None] * inv[None, :]
    cos = jnp.cos(ang)[None, :, None, :]
    sin = jnp.sin(ang)[None, :, None, :]
    xf = x.astype(jnp.float32)
    x1, x2 = xf[..., : d // 2], xf[..., d // 2:]
    return jnp.concatenate([x1 * cos - x2 * sin, x2 * cos + x1 * sin], axis=-1)


def causal_conv(u, w):
    K, C = w.shape
    return lax.conv_general_dilated(u, w[:, None, :].astype(u.dtype), window_strides=(1,),
                                    padding=[(K - 1, 0)],
                                    dimension_numbers=("NWC", "WIO", "NWC"),
                                    feature_group_count=C)


def retention(q, k, v):
    B, T, H, dk = q.shape
    dv = v.shape[-1]
    L = CHUNK
    NC = T // L
    log_g = jnp.log1p(-jnp.exp2(-5.0 - jnp.arange(H, dtype=jnp.float32)))
    q = q.reshape(B, NC, L, H, dk)
    k = k.reshape(B, NC, L, H, dk)
    v = v.reshape(B, NC, L, H, dv)
    idx = jnp.arange(L, dtype=jnp.float32)
    diff = idx[:, None] - idx[None, :]
    dmask = jnp.where(diff >= 0, jnp.exp(log_g[:, None, None] * jnp.maximum(diff, 0.0)), 0.0)
    s = jnp.einsum('bcihd,bcjhd->bchij', q, k) * dmask[None, None]
    intra = jnp.einsum('bchij,bcjhe->bcihe', s, v)
    w_k = jnp.exp(log_g[None, :] * (L - 1.0 - idx)[:, None])
    kv = jnp.einsum('bcjhd,jh,bcjhe->bchde', k, w_k, v)
    g_L = jnp.exp(log_g * L)

    def step(R, kv_c):
        return R * g_L[None, :, None, None] + kv_c, R

    _, R_prev = lax.scan(step, jnp.zeros((B, H, dk, dv), jnp.float32), jnp.moveaxis(kv, 1, 0))
    R_prev = jnp.moveaxis(R_prev, 0, 1)
    w_q = jnp.exp(log_g[None, :] * (idx + 1.0)[:, None])
    inter = jnp.einsum('bcihd,bchde->bcihe', q, R_prev) * w_q[None, None, :, :, None]
    return (intra + inter).reshape(B, T, H, dv)


def mlstm(q, k, v, i_pre, f_pre):
    B, T, H, d = q.shape
    L = CHUNK
    NC = T // L
    k = k * (d ** -0.5)
    lf = jax.nn.log_sigmoid(f_pre)
    to_c = lambda a: a.reshape(B, NC, L, H, d).transpose(1, 0, 3, 2, 4)
    to_g = lambda a: a.reshape(B, NC, L, H).transpose(1, 0, 3, 2)
    causal = jnp.tril(jnp.ones((L, L), dtype=bool))

    def step(carry, xs):
        C, n, m = carry
        qb, kb, vb, ib, fb = xs
        b = jnp.cumsum(fb, axis=-1)
        logD = jnp.where(causal, b[..., :, None] - b[..., None, :] + ib[..., None, :], -jnp.inf)
        inter_log = b + m[..., None]
        m_t = jnp.maximum(inter_log, jnp.max(logD, axis=-1))
        D = jnp.exp(logD - m_t[..., None])
        w_inter = jnp.exp(inter_log - m_t)
        s = jnp.einsum('bhid,bhjd->bhij', qb, kb) * D
        num = jnp.einsum('bhij,bhjd->bhid', s, vb) + w_inter[..., None] * jnp.einsum('bhid,bhde->bhie', qb, C)
        den = jnp.sum(s, axis=-1) + w_inter * jnp.einsum('bhid,bhd->bhi', qb, n)
        h = num / jnp.maximum(jnp.abs(den), jnp.exp(-m_t))[..., None]
        b_L = b[..., -1]
        log_w = b_L[..., None] - b + ib
        m_new = jnp.maximum(b_L + m, jnp.max(log_w, axis=-1))
        w = jnp.exp(log_w - m_new[..., None])
        decay = jnp.exp(b_L + m - m_new)
        C = decay[..., None, None] * C + jnp.einsum('bhj,bhjd,bhje->bhde', w, kb, vb)
        n = decay[..., None] * n + jnp.einsum('bhj,bhjd->bhd', w, kb)
        return (C, n, m_new), h

    init = (jnp.zeros((B, H, d, d), jnp.float32), jnp.zeros((B, H, d), jnp.float32),
            jnp.zeros((B, H), jnp.float32))
    _, hs = lax.scan(step, init, (to_c(q), to_c(k), to_c(v), to_g(i_pre), to_g(lf)))
    return hs.transpose(1, 0, 3, 2, 4).reshape(B, T, H, d)


def retention_mlstm_mixer(h, w_in, conv_w, gate_b, head_g, w_out):
    B, T, _ = h.shape
    proj = h @ w_in.astype(h.dtype)
    rq, rk, rv, rg, mq, mk, mv, mo, mif = jnp.split(proj, RM_SPLITS, axis=-1)
    pos = jnp.arange(T)
    rq = rotary(rq.reshape(B, T, RET_HEADS, RET_DK), pos)
    rk = rotary(rk.reshape(B, T, RET_HEADS, RET_DK), pos) * (RET_DK ** -0.5)
    ret = retention(rq, rk, rv.reshape(B, T, RET_HEADS, RET_DV).astype(jnp.float32))
    ret = rms_norm(ret, head_g[:RET_WIDTH].reshape(RET_HEADS, RET_DV))
    ret = ret * jax.nn.silu(rg.reshape(B, T, RET_HEADS, RET_DV).astype(jnp.float32))
    mqk = jax.nn.silu(causal_conv(jnp.concatenate([mq, mk], axis=-1), conv_w)).astype(jnp.float32)
    mq, mk = mqk[..., :ML_WIDTH], mqk[..., ML_WIDTH:]
    gates = mif.astype(jnp.float32) + gate_b.astype(jnp.float32)
    ml = mlstm(mq.reshape(B, T, ML_HEADS, ML_DH), mk.reshape(B, T, ML_HEADS, ML_DH),
               mv.reshape(B, T, ML_HEADS, ML_DH).astype(jnp.float32),
               gates[..., :ML_HEADS], gates[..., ML_HEADS:])
    ml = rms_norm(ml, head_g[RET_WIDTH:].reshape(ML_HEADS, ML_DH))
    ml = ml * jax.nn.sigmoid(mo.reshape(B, T, ML_HEADS, ML_DH).astype(jnp.float32))
    cat = jnp.concatenate([ret.reshape(B, T, RET_WIDTH), ml.reshape(B, T, ML_WIDTH)], axis=-1)
    return cat.astype(h.dtype) @ w_out.astype(h.dtype)


def t5_bucket(dist):
    n = jnp.maximum(dist, 0)
    max_exact = N_BUCKETS // 2
    nf = jnp.maximum(n, 1).astype(jnp.float32)
    large = max_exact + (jnp.log(nf / max_exact) / math.log(MAX_DIST / max_exact)
                         * (N_BUCKETS - max_exact)).astype(jnp.int32)
    large = jnp.minimum(large, N_BUCKETS - 1)
    return jnp.where(n < max_exact, n, large)


def swa_sink_mixer(h, w_in, sinks, rel_bias, w_out):
    B, T, _ = h.shape
    L = ATT_BLOCK
    NB = T // L
    G = ATT_HEADS // KV_HEADS
    proj = h @ w_in.astype(h.dtype)
    q, k, v = jnp.split(proj, [ATT_HEADS * HEAD_DIM, (ATT_HEADS + KV_HEADS) * HEAD_DIM], axis=-1)
    q = q.reshape(B, NB, L, KV_HEADS, G, HEAD_DIM)
    k = k.reshape(B, T, KV_HEADS, HEAD_DIM)
    v = v.reshape(B, T, KV_HEADS, HEAD_DIM)
    band = lambda a: jnp.concatenate(
        [jnp.pad(a, ((0, 0), (L, 0), (0, 0), (0, 0)))[:, :T].reshape(B, NB, L, KV_HEADS, HEAD_DIM),
         a.reshape(B, NB, L, KV_HEADS, HEAD_DIM)], axis=2)
    kb, vb = band(k), band(v)
    s = jnp.einsum('bnikgd,bnjkd->bnkgij', q, kb,
                   preferred_element_type=jnp.float32) * (HEAD_DIM ** -0.5)
    i = jnp.arange(L)
    j = jnp.arange(2 * L)
    dist = (L + i)[:, None] - j[None, :]
    bias = rel_bias.astype(jnp.float32)[t5_bucket(dist)]
    bias = bias.transpose(2, 0, 1).reshape(KV_HEADS, G, L, 2 * L)
    key_pos = jnp.arange(NB)[:, None] * L - L + j[None, :]
    valid = ((dist >= 0) & (dist < WINDOW))[None] & (key_pos >= 0)[:, None, :]
    s = jnp.where(valid[None, :, None, None], s + bias[None, None], -jnp.inf)
    sink = sinks.astype(jnp.float32).reshape(KV_HEADS, G)[None, None, :, :, None, None]
    mx = jnp.maximum(jnp.max(s, axis=-1, keepdims=True), sink)
    p = jnp.exp(s - mx)
    p = p / (jnp.sum(p, axis=-1, keepdims=True) + jnp.exp(sink - mx))
    o = jnp.einsum('bnkgij,bnjkd->bnikgd', p, vb.astype(jnp.float32))
    return o.reshape(B, T, ATT_HEADS * HEAD_DIM).astype(h.dtype) @ w_out.astype(h.dtype)


def swiglu(h, w_gu, w_down):
    gu = h @ w_gu.astype(h.dtype)
    g, u = gu[..., :D_FF], gu[..., D_FF:]
    return (jax.nn.silu(g) * u) @ w_down.astype(h.dtype)


def setup_inputs(seed: int = 0) -> dict:
    key = jax.random.key(seed)
    ks = jax.random.split(key, 16)
    n_even = (DEPTH + 1) // 2
    n_odd = DEPTH // 2
    f32 = jnp.float32
    nrm = lambda k, shape, scale: jax.random.normal(k, shape, f32) * scale
    mix_w = RET_WIDTH + ML_WIDTH
    f_bias = jnp.linspace(3.0, 6.0, ML_HEADS, dtype=f32)
    return {
        "x": nrm(ks[0], (BATCH, SEQ, D_MODEL), 1.0),
        "rel_bias": nrm(ks[1], (N_BUCKETS, ATT_HEADS), 0.5),
        "norm_g": 1.0 + nrm(ks[2], (DEPTH, 4, D_MODEL), 0.05),
        "ffn_w_gu": nrm(ks[3], (DEPTH, D_MODEL, 2 * D_FF), D_MODEL ** -0.5),
        "ffn_w_down": nrm(ks[4], (DEPTH, D_FF, D_MODEL), D_FF ** -0.5),
        "rm_w_in": nrm(ks[5], (n_even, D_MODEL, RM_COLS), D_MODEL ** -0.5),
        "ml_conv_w": nrm(ks[6], (n_even, CONV_W, 2 * ML_WIDTH), CONV_W ** -0.5),
        "ml_gate_b": jnp.concatenate([nrm(ks[7], (n_even, ML_HEADS), 0.1),
                                      f_bias + nrm(ks[8], (n_even, ML_HEADS), 0.1)], axis=-1),
        "rm_head_g": 1.0 + nrm(ks[9], (n_even, mix_w), 0.05),
        "rm_w_out": nrm(ks[10], (n_even, mix_w, D_MODEL), mix_w ** -0.5),
        "swa_w_in": nrm(ks[11], (n_odd, D_MODEL, SWA_COLS), D_MODEL ** -0.5),
        "swa_sinks": nrm(ks[12], (n_odd, ATT_HEADS), 0.5),
        "swa_w_out": nrm(ks[13], (n_odd, ATT_HEADS * HEAD_DIM, D_MODEL), (ATT_HEADS * HEAD_DIM) ** -0.5),
    }


def reference(x, rel_bias, norm_g, ffn_w_gu, ffn_w_down, rm_w_in, ml_conv_w, ml_gate_b,
              rm_head_g, rm_w_out, swa_w_in, swa_sinks, swa_w_out):
    for layer in range(DEPTH):
        g = norm_g[layer]
        h = rms_norm(x, g[0])
        if layer % 2 == 0:
            e = layer // 2
            h = retention_mlstm_mixer(h, rm_w_in[e], ml_conv_w[e], ml_gate_b[e], rm_head_g[e], rm_w_out[e])
        else:
            o = layer // 2
            h = swa_sink_mixer(h, swa_w_in[o], swa_sinks[o], rel_bias, swa_w_out[o])
        x = x + rms_norm(h, g[1])
        h = swiglu(rms_norm(x, g[2]), ffn_w_gu[layer], ffn_w_down[layer])
        x = x + rms_norm(h, g[3])
    return x
```

```cpp
#include <hip/hip_runtime.h>
#include <hip/hip_cooperative_groups.h>
#include <cstdio>
#include <cstdint>
namespace cg = cooperative_groups;

#define LAS __attribute__((address_space(3)))
typedef unsigned short bf16_t;
typedef short bf16x8 __attribute__((ext_vector_type(8)));
typedef float f32x4 __attribute__((ext_vector_type(4)));
typedef unsigned u32x4 __attribute__((ext_vector_type(4)));
typedef unsigned u32x2 __attribute__((ext_vector_type(2)));

namespace pg8 {
#define PG8_LAS __attribute__((address_space(3)))
constexpr int BM = 256, BK = 64, HALF = 128, HTB = HALF * BK * 2, STAGE_BYTES = 8 * HTB, NXCD = 8, WGM = 8;

__host__ __device__ __forceinline__ int lds_byte(int r, int c) { const int st = (r >> 4) * 2 + (c >> 5), rr = r & 15, cc = c & 31, ob = rr * 64 + cc * 2; return st * 1024 + (ob ^ (((ob >> 9) & 1) << 5)); }
__host__ __device__ __forceinline__ void stage_rc(int b, int& R, int& C) { const int st = b / 1024, sb = b % 1024, swz = sb ^ (((sb >> 9) & 1) << 5); R = (st >> 1) * 16 + swz / 64; C = (st & 1) * 32 + (swz % 64) / 2; }
__host__ __device__ __forceinline__ int perm32(int rho) { const int n = rho >> 4, i = rho & 15; return 8 * (i >> 2) + 4 * n + (i & 3); }

struct Unit { int pm, pn; };
struct Gemm { const bf16_t* A; const bf16_t* Bt; int M, N, K; };

struct StaticOrder {
    int nM, nN, nwg, G, c;
    __host__ __device__ void init(int M, int N, int G_, int c_) { nM = M / BM; nN = N / BM; nwg = nM * nN; G = G_; c = c_; }
    __host__ __device__ bool next(int i, Unit& u) const {
        const long L = (long)i * G + c; if (L >= nwg) return false;
        int wgid = (int)L; { const int q = nwg / NXCD, r = nwg % NXCD, xcd = wgid % NXCD, off = wgid / NXCD; wgid = (xcd < r ? xcd * (q + 1) : r * (q + 1) + (xcd - r) * q) + off; }
        const int nig = WGM * nN, gid = wgid / nig, fm = gid * WGM, gsz = (nM - fm) < WGM ? (nM - fm) : WGM;
        u.pm = fm + ((wgid % nig) % gsz); u.pn = (wgid % nig) / gsz; return true;
    }
    __device__ __forceinline__ void a_ready(const Unit&) const {}
    __device__ __forceinline__ void done(const Unit&) const {}
};

__device__ __forceinline__ unsigned cvt_pk_bf16(float lo, float hi) { unsigned r; asm volatile("v_cvt_pk_bf16_f32 %0, %1, %2" : "=v"(r) : "v"(lo), "v"(hi)); return r; }

template <class Epi, class Sched, bool ALIGN_EPI = false, bool SP2 = false>
__device__ __forceinline__ void gemm_phase(PG8_LAS unsigned char* lds, const Gemm g, const Sched& S, const Epi& E) {
    const int tid = threadIdx.x, wid = __builtin_amdgcn_readfirstlane(tid >> 6), lane = tid & 63, wr = wid >> 2, wc = wid & 3, fr = lane & 15, fq = lane >> 4;
    const int K = g.K, nt = K / BK;
    unsigned voffA[2], voffB[2];
#pragma unroll
    for (int i = 0; i < 2; ++i) { int R, C; stage_rc(tid * 16 + i * 8192, R, C); const int Rb = Epi::PERM ? ((R & ~31) + perm32(R & 31)) : R;
        voffA[i] = (unsigned)(R * K + C) * 2u; voffB[i] = (unsigned)(Rb * K + C) * 2u; }
    const size_t kstep = (size_t)(BK * 2);
    const size_t hstep = (size_t)HALF * K * 2;
    const size_t tstep = 2 * hstep;
    const unsigned ldsw = (unsigned)wid * 1024u;
    const int aoff = lds_byte(wr * 64 + fr, fq * 8), boff = lds_byte(wc * 32 + fr, fq * 8);
#define PG8_SA(b, h) (((b) * 2 + (h)) * HTB)
#define PG8_SB(b, h) ((4 + (b) * 2 + (h)) * HTB)
#define PG8_STAGE(bufoff, gbase, voff) do { _Pragma("unroll") for (int _i = 0; _i < 2; ++_i) \
        __builtin_amdgcn_global_load_lds((const unsigned*)((const char*)(gbase) + (voff)[_i]), (PG8_LAS unsigned*)(lds + (bufoff) + ldsw + _i * 8192), 16, 0, 0); } while (0)
#define PG8_LDA(dst, b, h) do { _Pragma("unroll") for (int m = 0; m < 4; ++m) _Pragma("unroll") for (int k = 0; k < 2; ++k) dst[m][k] = *(const PG8_LAS bf16x8*)(lds + PG8_SA(b, h) + aoff + m * 2048 + k * 1024); } while (0)
#define PG8_LDB(dst, b, h) do { _Pragma("unroll") for (int n = 0; n < 2; ++n) _Pragma("unroll") for (int k = 0; k < 2; ++k) dst[n][k] = *(const PG8_LAS bf16x8*)(lds + PG8_SB(b, h) + boff + n * 2048 + k * 1024); } while (0)
#define PG8_MMA(ai, bj, At, Bt) do { __builtin_amdgcn_s_setprio(1); _Pragma("unroll") for (int m = 0; m < 4; ++m) _Pragma("unroll") for (int n = 0; n < 2; ++n) _Pragma("unroll") for (int k = 0; k < 2; ++k) \
        acc[ai][bj][m][n] = __builtin_amdgcn_mfma_f32_16x16x32_bf16(Bt[n][k], At[m][k], acc[ai][bj][m][n], 0, 0, 0); __builtin_amdgcn_s_setprio(0); } while (0)
#define PG8_WAIT_V(n) asm volatile("s_waitcnt vmcnt(" #n ")" ::: "memory")
#define PG8_WAIT_L(n) asm volatile("s_waitcnt lgkmcnt(" #n ")" ::: "memory")
#define PG8_BAR __builtin_amdgcn_s_barrier()
#define PG8_SCHED __builtin_amdgcn_sched_barrier(0)
    Unit cur, nxt; int ui = 0;
    if (!S.next(0, cur)) return;
    f32x4 acc[2][2][4][2];
#pragma unroll
    for (int a = 0; a < 2; ++a)
#pragma unroll
        for (int b = 0; b < 2; ++b)
#pragma unroll
            for (int m = 0; m < 4; ++m)
#pragma unroll
                for (int n = 0; n < 2; ++n) acc[a][b][m][n] = (f32x4){0.f, 0.f, 0.f, 0.f};
    bf16x8 At[4][2], B0[2][2], B1[2][2];
    const char* cA = (const char*)g.A + (size_t)cur.pm * tstep; const char* cB = (const char*)g.Bt + (size_t)cur.pn * tstep;
    S.a_ready(cur);
    if constexpr (SP2) {
        PG8_STAGE(PG8_SB(0, 0), cB, voffB); PG8_STAGE(PG8_SB(0, 1), cB + hstep, voffB); PG8_STAGE(PG8_SA(0, 0), cA, voffA); PG8_STAGE(PG8_SA(0, 1), cA + hstep, voffA);
        if (wr == 1) PG8_BAR;
        PG8_WAIT_V(2); PG8_BAR;
        PG8_STAGE(PG8_SB(1, 0), cB + kstep, voffB); PG8_STAGE(PG8_SA(1, 0), cA + kstep, voffA); PG8_STAGE(PG8_SB(1, 1), cB + hstep + kstep, voffB);
        PG8_WAIT_V(6); PG8_BAR;
    } else {
        PG8_STAGE(PG8_SB(0, 0), cB, voffB); PG8_STAGE(PG8_SA(0, 0), cA, voffA); PG8_STAGE(PG8_SB(0, 1), cB + hstep, voffB); PG8_STAGE(PG8_SA(0, 1), cA + hstep, voffA);
        if (wr == 1) PG8_BAR;
        PG8_WAIT_V(4); PG8_BAR;
        PG8_STAGE(PG8_SB(1, 0), cB + kstep, voffB); PG8_STAGE(PG8_SA(1, 0), cA + kstep, voffA); PG8_STAGE(PG8_SB(1, 1), cB + hstep + kstep, voffB);
        PG8_WAIT_V(6); PG8_BAR;
    }
    for (;;) {
        const bool has_next = S.next(ui + 1, nxt);
        const char* nA = has_next ? (const char*)g.A + (size_t)nxt.pm * tstep : cA; const char* nB = has_next ? (const char*)g.Bt + (size_t)nxt.pn * tstep : cB;
        for (int t = 0; t < nt; t += 2) {
            const bool last = (t == nt - 2);
            const char* a1 = cA + (size_t)(t + 1) * kstep;
            const char* a2 = last ? nA : cA + (size_t)(t + 2) * kstep; const char* b2 = last ? nB : cB + (size_t)(t + 2) * kstep;
            const char* a3 = a2 + kstep; const char* b3 = b2 + kstep;
            if (last && has_next) S.a_ready(nxt);
            if constexpr (SP2) {
            PG8_LDB(B0, 0, 0); PG8_LDB(B1, 0, 1); PG8_SCHED; PG8_LDA(At, 0, 0); PG8_STAGE(PG8_SA(1, 1), a1 + hstep, voffA);
            PG8_WAIT_V(8); PG8_WAIT_L(0); PG8_BAR; PG8_MMA(0, 0, At, B0); PG8_MMA(0, 1, At, B1); PG8_BAR; PG8_SCHED;
            PG8_LDA(At, 0, 1); PG8_STAGE(PG8_SB(0, 0), b2, voffB); PG8_STAGE(PG8_SB(0, 1), b2 + hstep, voffB); PG8_STAGE(PG8_SA(0, 0), a2, voffA);
            PG8_WAIT_V(8); PG8_WAIT_L(0); PG8_BAR; PG8_MMA(1, 0, At, B0); PG8_MMA(1, 1, At, B1); PG8_BAR; PG8_SCHED;
            PG8_LDB(B0, 1, 0); PG8_LDB(B1, 1, 1); PG8_SCHED; PG8_LDA(At, 1, 0); PG8_STAGE(PG8_SA(0, 1), a2 + hstep, voffA);
            PG8_WAIT_V(8); PG8_WAIT_L(0); PG8_BAR; PG8_MMA(0, 0, At, B0); PG8_MMA(0, 1, At, B1); PG8_BAR; PG8_SCHED;
            PG8_LDA(At, 1, 1); PG8_STAGE(PG8_SB(1, 0), b3, voffB); PG8_STAGE(PG8_SB(1, 1), b3 + hstep, voffB); PG8_STAGE(PG8_SA(1, 0), a3, voffA);
            PG8_WAIT_V(8); PG8_WAIT_L(0); PG8_BAR; PG8_MMA(1, 0, At, B0); PG8_MMA(1, 1, At, B1); PG8_BAR; PG8_SCHED;
            } else {
            PG8_LDB(B0, 0, 0); PG8_SCHED; PG8_LDA(At, 0, 0); PG8_STAGE(PG8_SA(1, 1), a1 + hstep, voffA);
            PG8_WAIT_L(8); PG8_BAR; PG8_WAIT_L(0); PG8_MMA(0, 0, At, B0); PG8_BAR; PG8_SCHED;
            PG8_LDB(B1, 0, 1); PG8_STAGE(PG8_SB(0, 0), b2, voffB);
            PG8_BAR; PG8_WAIT_L(0); PG8_MMA(0, 1, At, B1); PG8_BAR;
            PG8_LDA(At, 0, 1); PG8_STAGE(PG8_SA(0, 0), a2, voffA);
            PG8_BAR; PG8_WAIT_L(0); PG8_MMA(1, 0, At, B0); PG8_BAR; PG8_SCHED;
            PG8_STAGE(PG8_SB(0, 1), b2 + hstep, voffB);
            PG8_WAIT_V(6); PG8_BAR; PG8_MMA(1, 1, At, B1); PG8_BAR;
            PG8_LDB(B0, 1, 0); PG8_SCHED; PG8_LDA(At, 1, 0); PG8_STAGE(PG8_SA(0, 1), a2 + hstep, voffA);
            PG8_WAIT_L(8); PG8_BAR; PG8_WAIT_L(0); PG8_MMA(0, 0, At, B0); PG8_BAR; PG8_SCHED;
            PG8_LDB(B1, 1, 1); PG8_STAGE(PG8_SB(1, 0), b3, voffB);
            PG8_BAR; PG8_WAIT_L(0); PG8_MMA(0, 1, At, B1); PG8_BAR;
            PG8_LDA(At, 1, 1); PG8_STAGE(PG8_SA(1, 0), a3, voffA);
            PG8_BAR; PG8_WAIT_L(0); PG8_MMA(1, 0, At, B0); PG8_BAR; PG8_SCHED;
            PG8_STAGE(PG8_SB(1, 1), b3 + hstep, voffB);
            PG8_WAIT_V(6); PG8_BAR; PG8_MMA(1, 1, At, B1); PG8_BAR;
            }
        }
        if constexpr (ALIGN_EPI) { if (wr == 0) PG8_BAR; }
        if constexpr (!Epi::AFTER_DRAIN) { E(acc, cur, wr, wc, fr, fq); S.done(cur); }
        if (!has_next) break;
#pragma unroll
        for (int a = 0; a < 2; ++a)
#pragma unroll
            for (int b = 0; b < 2; ++b)
#pragma unroll
                for (int m = 0; m < 4; ++m)
#pragma unroll
                    for (int n = 0; n < 2; ++n) acc[a][b][m][n] = (f32x4){0.f, 0.f, 0.f, 0.f};
        cur = nxt; cA = nA; cB = nB; ++ui;
        if constexpr (ALIGN_EPI) { if (wr == 1) PG8_BAR; }
    }
    PG8_WAIT_V(0);
    if constexpr (!ALIGN_EPI) { if (wr == 0) PG8_BAR; }
    PG8_BAR;
#undef PG8_SA
#undef PG8_SB
#undef PG8_STAGE
#undef PG8_LDA
#undef PG8_LDB
#undef PG8_MMA
#undef PG8_WAIT_V
#undef PG8_WAIT_L
#undef PG8_BAR
#undef PG8_SCHED
}
}

constexpr int M_TOK = 16384, DM = 2048, SEQ_T = 4096, NPROJ = 8192, RMCOLS = 8200, FF = 5632, NQKV = 2560;
constexpr float EPS = 1e-6f;
constexpr float LOG2E = 1.4426950408889634f;
constexpr int LDS_BYTES = 147456;

constexpr size_t OFF_WIN = 0;
constexpr size_t OFF_WOUT0 = OFF_WIN + (size_t)NPROJ * DM * 2;
constexpr size_t OFF_WGU0 = OFF_WOUT0 + (size_t)DM * DM * 2;
constexpr size_t OFF_WD0 = OFF_WGU0 + (size_t)2 * FF * DM * 2;
constexpr size_t OFF_WSWA = OFF_WD0 + (size_t)DM * FF * 2;
constexpr size_t OFF_WO1 = OFF_WSWA + (size_t)NQKV * DM * 2;
constexpr size_t OFF_WGU1 = OFF_WO1 + (size_t)DM * DM * 2;
constexpr size_t OFF_WD1 = OFF_WGU1 + (size_t)2 * FF * DM * 2;
constexpr size_t OFF_COS = OFF_WD1 + (size_t)DM * FF * 2;
constexpr size_t OFF_SIN = OFF_COS + (size_t)SEQ_T * 128 * 4;
constexpr size_t OFF_GATES = OFF_SIN + (size_t)SEQ_T * 128 * 4;
constexpr size_t OFF_BIAS = OFF_GATES + (size_t)M_TOK * 8 * 4;
constexpr size_t OFF_A = OFF_BIAS + 32 * 128 * 4;
constexpr size_t OFF_Y = OFF_A + (size_t)M_TOK * NPROJ * 2;
constexpr size_t OFF_H = OFF_Y + (size_t)M_TOK * DM * 4;
constexpr size_t OFF_CTL = OFF_H + (size_t)M_TOK * DM * 2;
constexpr size_t CTL_BYTES = 16384;
constexpr size_t GA_BYTES = (size_t)16 * SEQ_T * 4;
constexpr size_t OFF_GA_ROWL = OFF_CTL + CTL_BYTES, OFF_GA_COLL = OFF_GA_ROWL + GA_BYTES, OFF_GA_WQ = OFF_GA_COLL + GA_BYTES, OFF_GA_WCOL = OFF_GA_WQ + GA_BYTES,
                 OFF_GA_FLR = OFF_GA_WCOL + GA_BYTES, OFF_DENI = OFF_GA_FLR + GA_BYTES, OFF_DENE = OFF_DENI + GA_BYTES, OFF_GA_DEC = OFF_DENE + GA_BYTES;
constexpr size_t WS_END = OFF_GA_DEC + 4096;

__device__ __forceinline__ unsigned f2bf(float f) { unsigned u = __builtin_bit_cast(unsigned, f); return (u + 0x7fffu + ((u >> 16) & 1u)) >> 16; }
__device__ __forceinline__ unsigned pk2(float lo, float hi) { return pg8::cvt_pk_bf16(lo, hi); }
__device__ __forceinline__ float bflo(unsigned u) { return __uint_as_float(u << 16); }
__device__ __forceinline__ float bfhi(unsigned u) { return __uint_as_float(u & 0xffff0000u); }
template <int CTRL> __device__ __forceinline__ float dppf(float v) { return __int_as_float(__builtin_amdgcn_update_dpp(0, __float_as_int(v), CTRL, 0xf, 0xf, false)); }
__device__ __forceinline__ float row_max16(float v) { v = fmaxf(v, dppf<0x121>(v)); v = fmaxf(v, dppf<0x122>(v)); v = fmaxf(v, dppf<0x124>(v)); v = fmaxf(v, dppf<0x128>(v)); return v; }
__device__ __forceinline__ float row_sum16(float v) { v += dppf<0x121>(v); v += dppf<0x122>(v); v += dppf<0x124>(v); v += dppf<0x128>(v); return v; }
__device__ __forceinline__ float wave_sum(float v) {
    v = row_sum16(v);
    const int iv = __float_as_int(v);
    const float r0 = __int_as_float(__builtin_amdgcn_readlane(iv, 0)), r1 = __int_as_float(__builtin_amdgcn_readlane(iv, 16));
    const float r2 = __int_as_float(__builtin_amdgcn_readlane(iv, 32)), r3 = __int_as_float(__builtin_amdgcn_readlane(iv, 48));
    return (r0 + r1) + (r2 + r3);
}
__device__ __forceinline__ float siluf(float g) { return g / (1.f + __expf(-g)); }
__device__ __forceinline__ float sigmf(float g) { return 1.f / (1.f + __expf(-g)); }
#define MFMA16(a, b, c) __builtin_amdgcn_mfma_f32_16x16x32_bf16((a), (b), (c), 0, 0, 0)
#define LDS_WAIT() asm volatile("s_waitcnt lgkmcnt(0)" ::: "memory")

struct EpiProj0 {
    static constexpr bool PERM = true, AFTER_DRAIN = false;
    bf16_t* O; const float* cosT; const float* sinT;
    __device__ __forceinline__ void operator()(const f32x4 (&acc)[2][2][4][2], const pg8::Unit& u, int wr, int wc, int fr, int fq) const {
        __builtin_amdgcn_sched_barrier(0); asm volatile("s_nop 7\n\ts_nop 7\n\ts_nop 7" ::: "memory"); __builtin_amdgcn_sched_barrier(0);
        const int grp = u.pn >> 2;
        const int row0 = u.pm * 256 + wr * 64 + fr;
        const int cl = wc * 32 + 8 * fq;
#pragma unroll
        for (int ai = 0; ai < 2; ++ai)
#pragma unroll
            for (int m = 0; m < 4; ++m) {
                const int row = row0 + ai * 128 + m * 16;
                bf16_t* rowp = O + (size_t)row * NPROJ + u.pn * 256 + cl;
                f32x4 v00 = acc[ai][0][m][0], v01 = acc[ai][0][m][1], v10 = acc[ai][1][m][0], v11 = acc[ai][1][m][1];
                if (grp < 2) {
                    const int pos = row & (SEQ_T - 1);
                    const float sc = (grp == 1) ? 0.0625f : 1.0f;
                    const f32x4 c0 = *(const f32x4*)(cosT + pos * 128 + cl), c1 = *(const f32x4*)(cosT + pos * 128 + cl + 4);
                    const f32x4 s0 = *(const f32x4*)(sinT + pos * 128 + cl), s1 = *(const f32x4*)(sinT + pos * 128 + cl + 4);
                    const f32x4 a0 = (v00 * c0 - v10 * s0) * sc, a1 = (v01 * c1 - v11 * s1) * sc;
                    const f32x4 b0 = (v10 * c0 + v00 * s0) * sc, b1 = (v11 * c1 + v01 * s1) * sc;
                    v00 = a0; v01 = a1; v10 = b0; v11 = b1;
                }
                u32x4 w0, w1;
                w0.x = pk2(v00[0], v00[1]); w0.y = pk2(v00[2], v00[3]); w0.z = pk2(v01[0], v01[1]); w0.w = pk2(v01[2], v01[3]);
                w1.x = pk2(v10[0], v10[1]); w1.y = pk2(v10[2], v10[3]); w1.z = pk2(v11[0], v11[1]); w1.w = pk2(v11[2], v11[3]);
                *(u32x4*)(rowp) = w0;
                *(u32x4*)(rowp + 128) = w1;
            }
    }
};
struct EpiBf16 {
    static constexpr bool PERM = true, AFTER_DRAIN = false;
    bf16_t* O; int ldc;
    __device__ __forceinline__ void operator()(const f32x4 (&acc)[2][2][4][2], const pg8::Unit& u, int wr, int wc, int fr, int fq) const {
        __builtin_amdgcn_sched_barrier(0); asm volatile("s_nop 7\n\ts_nop 7\n\ts_nop 7" ::: "memory"); __builtin_amdgcn_sched_barrier(0);
        const int row0 = u.pm * 256 + wr * 64 + fr;
        const int col0 = u.pn * 256 + wc * 32 + 8 * fq;
#pragma unroll
        for (int ai = 0; ai < 2; ++ai)
#pragma unroll
            for (int m = 0; m < 4; ++m) {
                bf16_t* rowp = O + (size_t)(row0 + ai * 128 + m * 16) * ldc + col0;
#pragma unroll
                for (int bj = 0; bj < 2; ++bj) {
                    const f32x4 v0 = acc[ai][bj][m][0], v1 = acc[ai][bj][m][1];
                    u32x4 w; w.x = pk2(v0[0], v0[1]); w.y = pk2(v0[2], v0[3]); w.z = pk2(v1[0], v1[1]); w.w = pk2(v1[2], v1[3]);
                    *(u32x4*)(rowp + bj * 128) = w;
                }
            }
    }
};
struct EpiF32 {
    static constexpr bool PERM = false, AFTER_DRAIN = false;
    float* O; int ldc;
    __device__ __forceinline__ void operator()(const f32x4 (&acc)[2][2][4][2], const pg8::Unit& u, int wr, int wc, int fr, int fq) const {
        __builtin_amdgcn_sched_barrier(0); asm volatile("s_nop 7\n\ts_nop 7\n\ts_nop 7" ::: "memory"); __builtin_amdgcn_sched_barrier(0);
        const int row0 = u.pm * 256 + wr * 64 + fr;
        const int col0 = u.pn * 256 + wc * 32 + 4 * fq;
#pragma unroll
        for (int ai = 0; ai < 2; ++ai)
#pragma unroll
            for (int m = 0; m < 4; ++m) {
                float* rowp = O + (size_t)(row0 + ai * 128 + m * 16) * ldc + col0;
#pragma unroll
                for (int bj = 0; bj < 2; ++bj)
#pragma unroll
                    for (int n = 0; n < 2; ++n) *(f32x4*)(rowp + bj * 128 + n * 16) = acc[ai][bj][m][n];
            }
    }
};
struct EpiSwiGLU {
    static constexpr bool PERM = true, AFTER_DRAIN = false;
    bf16_t* O;
    __device__ __forceinline__ void operator()(const f32x4 (&acc)[2][2][4][2], const pg8::Unit& u, int wr, int wc, int fr, int fq) const {
        __builtin_amdgcn_sched_barrier(0); asm volatile("s_nop 7\n\ts_nop 7\n\ts_nop 7" ::: "memory"); __builtin_amdgcn_sched_barrier(0);
        const int row0 = u.pm * 256 + wr * 64 + fr;
        const int col0 = u.pn * 128 + wc * 32 + 8 * fq;
#pragma unroll
        for (int ai = 0; ai < 2; ++ai)
#pragma unroll
            for (int m = 0; m < 4; ++m) {
                bf16_t* rowp = O + (size_t)(row0 + ai * 128 + m * 16) * FF + col0;
                const f32x4 g0 = acc[ai][0][m][0], g1 = acc[ai][0][m][1], u0 = acc[ai][1][m][0], u1 = acc[ai][1][m][1];
                u32x4 w;
                w.x = pk2(siluf(g0[0]) * u0[0], siluf(g0[1]) * u0[1]); w.y = pk2(siluf(g0[2]) * u0[2], siluf(g0[3]) * u0[3]);
                w.z = pk2(siluf(g1[0]) * u1[0], siluf(g1[1]) * u1[1]); w.w = pk2(siluf(g1[2]) * u1[2], siluf(g1[3]) * u1[3]);
                *(u32x4*)(rowp) = w;
            }
    }
};

template <int MODE>
__device__ __forceinline__ void transpose_item(const float* W, int K, int ldw, int nblk, bf16_t* WT, LAS float* scr, int item, int lane) {
    const int kb = item / nblk, nb = item % nblk, k0 = 64 * kb, n0 = 32 * nb;
    f32x4 tv[8];
#pragma unroll
    for (int i = 0; i < 8; ++i) tv[i] = *(const f32x4*)(W + (size_t)(k0 + (lane >> 3) + 8 * i) * ldw + n0 + (lane & 7) * 4);
#pragma unroll
    for (int i = 0; i < 8; ++i) { LAS float* d = scr + ((lane >> 3) + 8 * i) * 33 + (lane & 7) * 4; d[0] = tv[i][0]; d[1] = tv[i][1]; d[2] = tv[i][2]; d[3] = tv[i][3]; }
    LDS_WAIT(); asm volatile("" ::: "memory");
    const int c = lane & 7;
#pragma unroll
    for (int j = 0; j < 4; ++j) {
        const int n = (lane >> 3) + 8 * j; const LAS float* s = scr + (8 * c) * 33 + n;
        u32x4 o; o.x = pk2(s[0 * 33], s[1 * 33]); o.y = pk2(s[2 * 33], s[3 * 33]); o.z = pk2(s[4 * 33], s[5 * 33]); o.w = pk2(s[6 * 33], s[7 * 33]);
        int dn = n0 + n;
        if (MODE == 1) { if (dn < FF) dn = (dn >> 7) * 256 + (dn & 127); else { const int d2 = dn - FF; dn = (d2 >> 7) * 256 + 128 + (d2 & 127); } }
        *(u32x4*)(WT + (size_t)dn * K + k0 + 8 * c) = o;
    }
    LDS_WAIT(); asm volatile("" ::: "memory");
}

struct TItem { const float* W; bf16_t* WT; int K, ldw, nblk, mode, idx; };
__device__ __forceinline__ void titem_load(const TItem& t, int lane, f32x4 (&tv)[8]) {
    const int kb = t.idx / t.nblk, nb = t.idx % t.nblk, k0 = 64 * kb, n0 = 32 * nb;
#pragma unroll
    for (int i = 0; i < 8; ++i) tv[i] = __builtin_nontemporal_load((const f32x4*)(t.W + (size_t)(k0 + (lane >> 3) + 8 * i) * t.ldw + n0 + (lane & 7) * 4));
}
__device__ __forceinline__ void titem_store(const TItem& t, int lane, const f32x4 (&tv)[8], LAS float* scr) {
    const int kb = t.idx / t.nblk, nb = t.idx % t.nblk, k0 = 64 * kb, n0 = 32 * nb;
#pragma unroll
    for (int i = 0; i < 8; ++i) { LAS float* d = scr + ((lane >> 3) + 8 * i) * 33 + (lane & 7) * 4; d[0] = tv[i][0]; d[1] = tv[i][1]; d[2] = tv[i][2]; d[3] = tv[i][3]; }
    LDS_WAIT(); asm volatile("" ::: "memory");
    const int c = lane & 7;
#pragma unroll
    for (int j = 0; j < 4; ++j) {
        const int n = (lane >> 3) + 8 * j; const LAS float* s = scr + (8 * c) * 33 + n;
        u32x4 o; o.x = pk2(s[0 * 33], s[1 * 33]); o.y = pk2(s[2 * 33], s[3 * 33]); o.z = pk2(s[4 * 33], s[5 * 33]); o.w = pk2(s[6 * 33], s[7 * 33]);
        int dn = n0 + n;
        if (t.mode == 1) { if (dn < FF) dn = (dn >> 7) * 256 + (dn & 127); else { const int d2 = dn - FF; dn = (d2 >> 7) * 256 + 128 + (d2 & 127); } }
        *(u32x4*)(t.WT + (size_t)dn * t.K + k0 + 8 * c) = o;
    }
    LDS_WAIT(); asm volatile("" ::: "memory");
}

struct Args { const float* in[13]; float* out; unsigned char* ws; int ph_lo, ph_hi; };

__device__ __forceinline__ int t5_bucket(int n) {
    if (n < 16) return n;
    const float v = logf((float)n / 16.0f) / 2.0794415416798357f * 16.0f;
    int l = 16 + (int)v; return l < 31 ? l : 31;
}

__device__ __forceinline__ void phase_prologue(LAS unsigned char* lds, const Args& a) {
    const int tid = threadIdx.x, lane = tid & 63, wave = tid >> 6;
    const int gw = blockIdx.x * 8 + wave, NGW = gridDim.x * 8;
    unsigned char* ws = a.ws;
    LAS float* scr = (LAS float*)(lds + wave * 16384);
    constexpr int I_IN = (DM / 64) * (NPROJ / 32), I_SQ = (DM / 64) * (DM / 32), I_GU = (DM / 64) * (2 * FF / 32), I_DN = (FF / 64) * (DM / 32), I_SWA = (DM / 64) * (NQKV / 32);
    constexpr int NITEMS = I_IN + 2 * I_SQ + 2 * I_GU + 2 * I_DN + I_SWA;
    auto decode = [&](int it) -> TItem {
        int r = it; TItem t;
        if (r < I_IN) { t = TItem{a.in[5], (bf16_t*)(ws + OFF_WIN), DM, RMCOLS, NPROJ / 32, 0, r}; return t; } r -= I_IN;
        if (r < I_SQ) { t = TItem{a.in[9], (bf16_t*)(ws + OFF_WOUT0), DM, DM, DM / 32, 0, r}; return t; } r -= I_SQ;
        if (r < I_GU) { t = TItem{a.in[3], (bf16_t*)(ws + OFF_WGU0), DM, 2 * FF, 2 * FF / 32, 1, r}; return t; } r -= I_GU;
        if (r < I_DN) { t = TItem{a.in[4], (bf16_t*)(ws + OFF_WD0), FF, DM, DM / 32, 0, r}; return t; } r -= I_DN;
        if (r < I_SWA) { t = TItem{a.in[10], (bf16_t*)(ws + OFF_WSWA), DM, NQKV, NQKV / 32, 0, r}; return t; } r -= I_SWA;
        if (r < I_SQ) { t = TItem{a.in[12], (bf16_t*)(ws + OFF_WO1), DM, DM, DM / 32, 0, r}; return t; } r -= I_SQ;
        if (r < I_GU) { t = TItem{a.in[3] + (size_t)DM * 2 * FF, (bf16_t*)(ws + OFF_WGU1), DM, 2 * FF, 2 * FF / 32, 1, r}; return t; } r -= I_GU;
        t = TItem{a.in[4] + (size_t)FF * DM, (bf16_t*)(ws + OFF_WD1), FF, DM, DM / 32, 0, r}; return t;
    };
    if (gw < NITEMS) {
        TItem cur = decode(gw); f32x4 tv[8]; titem_load(cur, lane, tv);
        for (int it = gw; it < NITEMS; it += NGW) {
            const int nx = it + NGW < NITEMS ? it + NGW : it;
            const TItem nxt = decode(nx); f32x4 tn[8]; titem_load(nxt, lane, tn);
            titem_store(cur, lane, tv, scr);
            cur = nxt;
#pragma unroll
            for (int i = 0; i < 8; ++i) tv[i] = tn[i];
        }
    }
    {
        float* cosT = (float*)(ws + OFF_COS); float* sinT = (float*)(ws + OFF_SIN);
        for (int idx = blockIdx.x * 512 + tid; idx < SEQ_T * 128; idx += gridDim.x * 512) {
            const int pos = idx >> 7, i = idx & 127;
            const float t = (float)i / 127.0f;
            const float inv = 1.0f / exp2f(13.287712379549449f * t);
            const float ang = (float)pos * inv;
            const double ad = (double)ang;
            const double nrev = rint(ad * 0.15915494309189535);
            const float rf = (float)(ad - nrev * 6.283185307179586);
            cosT[idx] = __cosf(rf); sinT[idx] = __sinf(rf);
        }
        float* biasT = (float*)(ws + OFF_BIAS);
        for (int idx = blockIdx.x * 512 + tid; idx < 32 * 128; idx += gridDim.x * 512) {
            const int h = idx >> 7, dist = idx & 127;
            biasT[idx] = a.in[1][t5_bucket(dist) * 32 + h];
        }
    }
    __syncthreads();
    LAS float* WgS = (LAS float*)lds;
    for (int idx = tid; idx < 8 * DM; idx += 512) { const int k = idx >> 3, c = idx & 7; WgS[c * DM + k] = a.in[5][(size_t)k * RMCOLS + NPROJ + c]; }
    __syncthreads();
    const float* x = a.in[0]; const float* g0 = a.in[2];
    bf16_t* hn = (bf16_t*)(ws + OFF_H); float* gates = (float*)(ws + OFF_GATES);
    f32x4 gv[8];
#pragma unroll
    for (int j = 0; j < 8; ++j) gv[j] = ((const f32x4*)g0)[lane + 64 * j];
    float gbias[8];
#pragma unroll
    for (int c = 0; c < 8; ++c) gbias[c] = a.in[7][c];
    f32x4 v[8];
    if (gw < M_TOK) {
#pragma unroll
        for (int j = 0; j < 8; ++j) v[j] = __builtin_nontemporal_load((const f32x4*)(x + (size_t)gw * DM) + lane + 64 * j);
    }
    for (int m = gw; m < M_TOK; m += NGW) {
        const int mn = m + NGW < M_TOK ? m + NGW : m;
        f32x4 vn[8];
#pragma unroll
        for (int j = 0; j < 8; ++j) vn[j] = __builtin_nontemporal_load((const f32x4*)(x + (size_t)mn * DM) + lane + 64 * j);
        float ss = 0.f;
#pragma unroll
        for (int j = 0; j < 8; ++j) ss += (v[j][0] * v[j][0] + v[j][1] * v[j][1]) + (v[j][2] * v[j][2] + v[j][3] * v[j][3]);
        const float rs = rsqrtf(wave_sum(ss) * (1.0f / DM) + EPS);
        u32x2* o8 = (u32x2*)(hn + (size_t)m * DM) + lane;
#pragma unroll
        for (int j = 0; j < 8; ++j) { v[j] = v[j] * rs * gv[j]; u32x2 o; o.x = pk2(v[j][0], v[j][1]); o.y = pk2(v[j][2], v[j][3]); o8[64 * j] = o; }
        float gsum[8];
#pragma unroll
        for (int c = 0; c < 8; ++c) {
            float s_ = 0.f;
#pragma unroll
            for (int j = 0; j < 8; ++j) { const f32x4 w4 = *(const LAS f32x4*)(WgS + c * DM + 4 * lane + 256 * j); s_ += (v[j][0] * w4[0] + v[j][1] * w4[1]) + (v[j][2] * w4[2] + v[j][3] * w4[3]); }
            gsum[c] = wave_sum(s_);
        }
        if (lane == 0) {
#pragma unroll
            for (int c = 0; c < 8; ++c) gates[(size_t)m * 8 + c] = gsum[c] + gbias[c];
        }
#pragma unroll
        for (int j = 0; j < 8; ++j) v[j] = vn[j];
    }
    __syncthreads();
}

template <bool XIN_BF16>
__device__ __forceinline__ void normres_load(const void* xin_, const bf16_t* y, int m, int lane, u32x2 (&yv)[8], f32x4 (&xv)[8]) {
    const u32x2* yr = (const u32x2*)(y + (size_t)m * DM) + lane;
#pragma unroll
    for (int j = 0; j < 8; ++j) {
        yv[j] = __builtin_nontemporal_load(yr + 64 * j);
        if (XIN_BF16) { const u32x2 xx = __builtin_nontemporal_load((const u32x2*)((const bf16_t*)xin_ + (size_t)m * DM) + lane + 64 * j); xv[j] = (f32x4){bflo(xx.x), bfhi(xx.x), bflo(xx.y), bfhi(xx.y)}; }
        else xv[j] = __builtin_nontemporal_load((const f32x4*)((const float*)xin_ + (size_t)m * DM) + lane + 64 * j);
    }
}
template <bool XIN_BF16, bool XOUT_BF16>
__device__ __forceinline__ void phase_normres(const void* xin_, void* xout_, const bf16_t* y, const float* gA, const float* gB, bf16_t* hn) {
    const int tid = threadIdx.x, lane = tid & 63, wave = tid >> 6;
    const int gw = blockIdx.x * 8 + wave, NGW = gridDim.x * 8;
    if (gw >= M_TOK) return;
    f32x4 gav[8], gbv[8];
#pragma unroll
    for (int j = 0; j < 8; ++j) { gav[j] = ((const f32x4*)gA)[lane + 64 * j]; gbv[j] = gB ? ((const f32x4*)gB)[lane + 64 * j] : (f32x4){0.f, 0.f, 0.f, 0.f}; }
    u32x2 yv[8]; f32x4 xv[8];
    normres_load<XIN_BF16>(xin_, y, gw, lane, yv, xv);
    for (int m = gw; m < M_TOK; m += NGW) {
        u32x2 yn[8]; f32x4 xn[8];
        const bool more = m + NGW < M_TOK;
        normres_load<XIN_BF16>(xin_, y, more ? m + NGW : m, lane, yn, xn);
        f32x4 v[8]; float ss = 0.f;
#pragma unroll
        for (int j = 0; j < 8; ++j) { v[j] = (f32x4){bflo(yv[j].x), bfhi(yv[j].x), bflo(yv[j].y), bfhi(yv[j].y)}; ss += (v[j][0] * v[j][0] + v[j][1] * v[j][1]) + (v[j][2] * v[j][2] + v[j][3] * v[j][3]); }
        const float rs = rsqrtf(wave_sum(ss) * (1.0f / DM) + EPS);
        float s2 = 0.f;
#pragma unroll
        for (int j = 0; j < 8; ++j) {
            const f32x4 ga = gav[j];
            xv[j] = xv[j] + v[j] * rs * ga;
            if (XOUT_BF16) { u32x2 o; o.x = pk2(xv[j][0], xv[j][1]); o.y = pk2(xv[j][2], xv[j][3]); __builtin_nontemporal_store(o, (u32x2*)((bf16_t*)xout_ + (size_t)m * DM) + lane + 64 * j); }
            else __builtin_nontemporal_store(xv[j], (f32x4*)((float*)xout_ + (size_t)m * DM) + lane + 64 * j);
            s2 += (xv[j][0] * xv[j][0] + xv[j][1] * xv[j][1]) + (xv[j][2] * xv[j][2] + xv[j][3] * xv[j][3]);
        }
        if (gB) {
            const float r2 = rsqrtf(wave_sum(s2) * (1.0f / DM) + EPS);
            u32x2* o8 = (u32x2*)(hn + (size_t)m * DM) + lane;
#pragma unroll
            for (int j = 0; j < 8; ++j) {
                const f32x4 gb = gbv[j];
                const f32x4 h = xv[j] * r2 * gb; u32x2 o; o.x = pk2(h[0], h[1]); o.y = pk2(h[2], h[3]); o8[64 * j] = o;
            }
        }
        if (!more) break;
#pragma unroll
        for (int j = 0; j < 8; ++j) { yv[j] = yn[j]; xv[j] = xn[j]; }
    }
}

__device__ __forceinline__ void combine_load(const bf16_t* mixI, const bf16_t* mixE, const float* denI, const float* denE, const float* flrA, const bf16_t* proj, int m, int lane,
                                             u32x2 (&vi)[8], u32x2 (&ve)[8], u32x2 (&gg)[8], float (&dn)[4], float (&fl)[4]) {
    const u32x2* ir = (const u32x2*)(mixI + (size_t)m * DM) + lane;
    const u32x2* er = (const u32x2*)(mixE + (size_t)m * DM) + lane;
    const bf16_t* pr = proj + (size_t)m * NPROJ;
#pragma unroll
    for (int j = 0; j < 8; ++j) { vi[j] = __builtin_nontemporal_load(ir + 64 * j); ve[j] = __builtin_nontemporal_load(er + 64 * j); gg[j] = __builtin_nontemporal_load((const u32x2*)(pr + (j < 4 ? 3072 + 256 * j : 7168 + 256 * (j - 4)) + 4 * lane)); }
    const int bb = m >> 12, pos = m & (SEQ_T - 1);
#pragma unroll
    for (int hh = 0; hh < 4; ++hh) { const int gi = (bb * 4 + hh) * SEQ_T + pos; dn[hh] = denI[gi] + denE[gi]; fl[hh] = flrA[gi]; }
}
__device__ __forceinline__ void phase_combine(const bf16_t* mixI, const bf16_t* mixE, const float* denI, const float* denE, const float* flrA, const bf16_t* proj, const float* head_g, bf16_t* cat) {
    const int tid = threadIdx.x, lane = tid & 63, wave = tid >> 6;
    const int gw = blockIdx.x * 8 + wave, NGW = gridDim.x * 8;
    if (gw >= M_TOK) return;
    f32x4 hgv[8];
#pragma unroll
    for (int j = 0; j < 8; ++j) hgv[j] = ((const f32x4*)head_g)[lane + 64 * j];
    u32x2 vi[8], ve[8], gg[8]; float dn[4], fl[4];
    combine_load(mixI, mixE, denI, denE, flrA, proj, gw, lane, vi, ve, gg, dn, fl);
    for (int m = gw; m < M_TOK; m += NGW) {
        u32x2 vin[8], ven[8], ggn[8]; float dnn[4], fln[4];
        combine_load(mixI, mixE, denI, denE, flrA, proj, m + NGW < M_TOK ? m + NGW : m, lane, vin, ven, ggn, dnn, fln);
        u32x2* o8 = (u32x2*)(cat + (size_t)m * DM) + lane;
#pragma unroll
        for (int j = 0; j < 8; ++j) {
            f32x4 v = (f32x4){bflo(vi[j].x) + bflo(ve[j].x), bfhi(vi[j].x) + bfhi(ve[j].x), bflo(vi[j].y) + bflo(ve[j].y), bfhi(vi[j].y) + bfhi(ve[j].y)};
            if (j >= 4) v = v * (1.0f / fmaxf(fabsf(dn[j - 4]), fl[j - 4]));
            const float ss = wave_sum((v[0] * v[0] + v[1] * v[1]) + (v[2] * v[2] + v[3] * v[3]));
            const float rs = rsqrtf(ss * (1.0f / 256.0f) + EPS);
            float g0 = bflo(gg[j].x), g1 = bfhi(gg[j].x), g2 = bflo(gg[j].y), g3 = bfhi(gg[j].y);
            if (j < 4) { g0 = siluf(g0); g1 = siluf(g1); g2 = siluf(g2); g3 = siluf(g3); }
            else { g0 = sigmf(g0); g1 = sigmf(g1); g2 = sigmf(g2); g3 = sigmf(g3); }
            u32x2 o; o.x = pk2(v[0] * rs * hgv[j][0] * g0, v[1] * rs * hgv[j][1] * g1); o.y = pk2(v[2] * rs * hgv[j][2] * g2, v[3] * rs * hgv[j][3] * g3);
            o8[64 * j] = o;
        }
#pragma unroll
        for (int j = 0; j < 8; ++j) { vi[j] = vin[j]; ve[j] = ven[j]; gg[j] = ggn[j]; }
#pragma unroll
        for (int hh = 0; hh < 4; ++hh) { dn[hh] = dnn[hh]; fl[hh] = fln[hh]; }
    }
}

constexpr int MX_P = 136;
constexpr int MX_RP = 264;
constexpr int MX_QS = 0, MX_KS = 34816, MX_RT = 69632, MX_V0 = MX_RT + 48 * MX_RP * 2, MX_V1 = MX_V0 + 48 * MX_P * 2, MX_ARR = MX_V1 + 48 * MX_P * 2;
static_assert(MX_ARR + 6 * 512 <= LDS_BYTES, "mixer LDS");

__device__ __forceinline__ void unpack8(const u32x4 v, f32x4& lo, f32x4& hi) { lo = (f32x4){bflo(v.x), bfhi(v.x), bflo(v.y), bfhi(v.y)}; hi = (f32x4){bflo(v.z), bfhi(v.z), bflo(v.w), bfhi(v.w)}; }
struct GateArrays { float* rowl; float* coll; float* wq; float* wcol; float* flr; float* dec; };
__device__ __forceinline__ float logsigf(float f) { return fminf(f, 0.f) - log1pf(__expf(-fabsf(f))); }
__device__ __forceinline__ void gate_prepass(const float* gates, const GateArrays& G, int unit, int lane) {
    const int b = unit >> 2, h = unit & 3;
    float m_prev = 0.f;
#pragma unroll 1
    for (int c8 = 0; c8 < 32; c8 += 8) {
        float gi0[8], gf0[8], gi1[8], gf1[8];
#pragma unroll
        for (int u = 0; u < 8; ++u) {
            const float* gp = gates + (size_t)(b * SEQ_T + (c8 + u) * 128 + 2 * lane) * 8;
            gi0[u] = gp[h]; gf0[u] = gp[4 + h]; gi1[u] = gp[8 + h]; gf1[u] = gp[12 + h];
        }
#pragma unroll
        for (int u = 0; u < 8; ++u) {
            const int c = c8 + u;
            const float i0 = gi0[u], f0 = gf0[u], i1 = gi1[u], f1 = gf1[u];
            const float l0 = logsigf(f0), l1 = logsigf(f1);
            const float s = l0 + l1; float inc = s;
#pragma unroll
            for (int o = 1; o < 64; o <<= 1) { const float t = __shfl_up(inc, o); if (lane >= o) inc += t; }
            const float exc = inc - s, b0 = exc + l0, b1 = exc + s;
            const float a0 = i0 - b0, a1 = i1 - b1;
            float incm = fmaxf(a0, a1);
#pragma unroll
            for (int o = 1; o < 64; o <<= 1) { const float t = __shfl_up(incm, o); if (lane >= o) incm = fmaxf(incm, t); }
            const float Amax = __shfl(incm, 63), bL = __shfl(b1, 63);
            float excm = __shfl_up(incm, 1); if (lane == 0) excm = -INFINITY;
            const float M0 = fmaxf(fmaxf(m_prev, excm), a0), M1 = fmaxf(M0, a1);
            const float Mlast = fmaxf(m_prev, Amax);
            const int gi = (b * 4 + h) * SEQ_T + c * 128 + 2 * lane;
            G.rowl[gi] = -M0 * LOG2E; G.rowl[gi + 1] = -M1 * LOG2E;
            G.coll[gi] = a0 * LOG2E; G.coll[gi + 1] = a1 * LOG2E;
            G.wq[gi] = __expf(m_prev - M0); G.wq[gi + 1] = __expf(m_prev - M1);
            G.wcol[gi] = __expf(a0 - Mlast); G.wcol[gi + 1] = __expf(a1 - Mlast);
            G.flr[gi] = __expf(-(b0 + M0)); G.flr[gi + 1] = __expf(-(b1 + M1));
            if (lane == 0) G.dec[(b * 4 + h) * 32 + c] = __expf(m_prev - Mlast);
            m_prev = bL + Mlast;
        }
    }
}

__device__ __forceinline__ void phase_conv(const bf16_t* proj, const float* convw, bf16_t* cq, const float* gates, const GateArrays& G) {
    if ((threadIdx.x >> 6) == 0) { for (int unit = blockIdx.x; unit < 16; unit += gridDim.x) gate_prepass(gates, G, unit, threadIdx.x & 63); }
    const int gt = blockIdx.x * 512 + threadIdx.x, NT = gridDim.x * 512;
    for (int u = gt; u < 1024 * 256; u += NT) {
        const int ch = (u & 255) * 8, strip = u >> 8, row0 = strip * 16;
        f32x4 w0[4], w1[4];
#pragma unroll
        for (int kk = 0; kk < 4; ++kk) { w0[kk] = *(const f32x4*)(convw + kk * 2048 + ch); w1[kk] = *(const f32x4*)(convw + kk * 2048 + ch + 4); }
        const float scale = ch >= 1024 ? 0.0625f : 1.0f;
        const bf16_t* src = proj + (size_t)row0 * NPROJ + 4096 + ch;
        bf16_t* dst = cq + (size_t)row0 * DM + ch;
        f32x4 a3l = {0.f, 0.f, 0.f, 0.f}, a3h = a3l, a2l = a3l, a2h = a3l, a1l = a3l, a1h = a3l;
        if ((row0 & (SEQ_T - 1)) != 0) {
            unpack8(*(const u32x4*)(src - 3 * NPROJ), a3l, a3h); unpack8(*(const u32x4*)(src - 2 * NPROJ), a2l, a2h); unpack8(*(const u32x4*)(src - 1 * NPROJ), a1l, a1h);
        }
#pragma unroll 1
        for (int r8 = 0; r8 < 16; r8 += 8) {
            u32x4 raw[8];
#pragma unroll
            for (int r = 0; r < 8; ++r) raw[r] = __builtin_nontemporal_load((const u32x4*)(src + (size_t)(r8 + r) * NPROJ));
#pragma unroll
            for (int r = 0; r < 8; ++r) {
                f32x4 cl, chh; unpack8(raw[r], cl, chh);
                const f32x4 sl_ = w0[0] * a3l + w0[1] * a2l + w0[2] * a1l + w0[3] * cl;
                const f32x4 sh_ = w1[0] * a3h + w1[1] * a2h + w1[2] * a1h + w1[3] * chh;
                u32x4 o;
                o.x = pk2(siluf(sl_[0]) * scale, siluf(sl_[1]) * scale); o.y = pk2(siluf(sl_[2]) * scale, siluf(sl_[3]) * scale);
                o.z = pk2(siluf(sh_[0]) * scale, siluf(sh_[1]) * scale); o.w = pk2(siluf(sh_[2]) * scale, siluf(sh_[3]) * scale);
                *(u32x4*)(dst + (size_t)(r8 + r) * DM) = o;
                a3l = a2l; a3h = a2h; a2l = a1l; a2h = a1h; a1l = cl; a1h = chh;
            }
        }
    }
}

template <int NE>
__device__ __forceinline__ void state_update(f32x4 (&St)[NE], float decay, const LAS bf16_t* KS, const LAS bf16_t* V1, int w, int fr, int fq) {
#pragma unroll
    for (int e = 0; e < NE; ++e) St[e] = St[e] * decay;
#pragma unroll
    for (int ks = 0; ks < 4; ++ks) {
        bf16x8 bg;
#pragma unroll
        for (int i = 0; i < 8; ++i) bg[i] = (short)KS[(ks * 32 + fq * 8 + i) * 136 + 16 * w + fr];
#pragma unroll
        for (int e = 0; e < NE; ++e) { const bf16x8 af = *(const LAS bf16x8*)(V1 + (16 * e + fr) * 136 + ks * 32 + fq * 8); St[e] = MFMA16(af, bg, St[e]); }
    }
}

template <int NE>
__device__ __forceinline__ void inter_piece(f32x4 (&Oi)[NE], f32x4 (&St)[NE], float decay, const LAS bf16_t* QS, const LAS bf16_t* KS, const LAS bf16_t* RTp, const LAS bf16_t* V1, int w, int fr, int fq) {
#pragma unroll
    for (int kk = 0; kk < 4; ++kk) {
        const bf16x8 af = *(const LAS bf16x8*)(QS + (16 * w + fr) * 136 + kk * 32 + fq * 8);
#pragma unroll
        for (int e = 0; e < NE; ++e) { const bf16x8 br = *(const LAS bf16x8*)(RTp + (16 * e + fr) * 264 + kk * 32 + fq * 8); Oi[e] = MFMA16(af, br, Oi[e]); }
    }
    state_update<NE>(St, decay, KS, V1, w, fr, fq);
}

constexpr int IT_RT = 0, IT_V1 = 2 * 48 * MX_RP * 2, IT_KP = IT_V1 + 2 * 48 * MX_P * 2, IT_END = IT_KP + 8 * 4096;
static_assert(IT_END <= LDS_BYTES - 64, "inter LDS");
template <int TYPE>
__device__ __forceinline__ void inter_item(LAS unsigned char* lds, const bf16_t* proj, const bf16_t* cq, const float* gaWQ, const float* gaWCOL, const float* gaDEC,
                                           bf16_t* mixE, float* denE, int b, int h, int sl) {
    constexpr int NE = TYPE ? 3 : 2;
    const int tid0 = threadIdx.x, w = __builtin_amdgcn_readfirstlane(tid0 >> 6);
    int tid = tid0;
    LAS bf16_t* RTb = (LAS bf16_t*)(lds + IT_RT); LAS bf16_t* V1b = (LAS bf16_t*)(lds + IT_V1);
    LAS bf16_t* KP = (LAS bf16_t*)(lds + IT_KP + w * 4096);
    const bf16_t* qsrc = TYPE ? cq + h * 256 : proj + h * 256;
    const bf16_t* ksrc = TYPE ? cq + 1024 + h * 256 : proj + 1024 + h * 256;
    const int qpitch = TYPE ? DM : NPROJ;
    const bf16_t* vsrc = proj + (TYPE ? 6144 + h * 256 : 2048 + h * 256) + sl * 32;
    const int g0 = (b * 4 + h) * SEQ_T;
    const float lg2 = log2f(1.0f - exp2f(-5.0f - (float)h));
    for (int i = tid; i < 2 * 48 * MX_RP / 2; i += 512) ((LAS unsigned*)RTb)[i] = 0u;
    for (int i = tid; i < 2 * 48 * MX_P / 2; i += 512) ((LAS unsigned*)V1b)[i] = 0u;
    f32x4 St[2][NE];
#pragma unroll
    for (int p = 0; p < 2; ++p)
#pragma unroll
        for (int e = 0; e < NE; ++e) St[p][e] = (f32x4){0.f, 0.f, 0.f, 0.f};
    bf16x8 qn[8]; u32x4 kb[2][4], pv; float pwc = 0.f, decay_n = 0.f; f32x4 wq_n = {0.f, 0.f, 0.f, 0.f};
    {
        const int lane = tid & 63, fr = lane & 15, fq = lane >> 4, t0 = b * SEQ_T;
        pv = *(const u32x4*)(vsrc + (size_t)(t0 + (tid >> 2)) * NPROJ + (tid & 3) * 8);
        if (TYPE == 1) { pwc = gaWCOL[g0 + (tid >> 2)]; decay_n = gaDEC[(b * 4 + h) * 32]; wq_n = *(const f32x4*)(gaWQ + g0 + 16 * w + fq * 4); }
#pragma unroll
        for (int kk = 0; kk < 8; ++kk) qn[kk] = *(const bf16x8*)(qsrc + (size_t)(t0 + 16 * w + fr) * qpitch + kk * 32 + fq * 8);
#pragma unroll
        for (int p = 0; p < 2; ++p)
#pragma unroll
            for (int k = 0; k < 4; ++k) kb[p][k] = *(const u32x4*)(ksrc + (size_t)(t0 + (lane >> 1) + 32 * k) * qpitch + p * 128 + 16 * w + (lane & 1) * 8);
    }
    __syncthreads();
    for (int c = 0; c < 32; ++c) {
        asm volatile("" : "+v"(tid));
        const int lane = tid & 63, fr = lane & 15, fq = lane >> 4;
        const int cn = c + 1 < 32 ? c + 1 : c;
        const int t0 = b * SEQ_T + c * 128, tn = b * SEQ_T + cn * 128;
        LAS bf16_t* RT = RTb + (c & 1) * 48 * MX_RP; LAS bf16_t* RTn = RTb + ((c & 1) ^ 1) * 48 * MX_RP;
        LAS bf16_t* V1 = V1b + (c & 1) * 48 * MX_P;
        float decay; f32x4 wq4;
        if (TYPE == 1) {
            decay = decay_n; wq4 = wq_n;
            decay_n = gaDEC[(b * 4 + h) * 32 + cn]; wq_n = *(const f32x4*)(gaWQ + g0 + cn * 128 + 16 * w + fq * 4);
        } else { decay = exp2f(128.0f * lg2); const float i0 = (float)(16 * w + fq * 4 + 1); wq4 = (f32x4){exp2f(i0 * lg2), exp2f((i0 + 1.f) * lg2), exp2f((i0 + 2.f) * lg2), exp2f((i0 + 3.f) * lg2)}; }
        {
            const int j = tid >> 2, part = tid & 3;
            const float wc_ = TYPE ? pwc : exp2f((float)(127 - j) * lg2);
            const unsigned uu[4] = {pv.x, pv.y, pv.z, pv.w};
#pragma unroll
            for (int q = 0; q < 4; ++q) {
                V1[(part * 8 + 2 * q) * MX_P + j] = (bf16_t)f2bf(bflo(uu[q]) * wc_); V1[(part * 8 + 2 * q + 1) * MX_P + j] = (bf16_t)f2bf(bfhi(uu[q]) * wc_);
            }
            if (TYPE == 1 && part == 0) V1[32 * MX_P + j] = (bf16_t)f2bf(wc_);
            pv = *(const u32x4*)(vsrc + (size_t)(tn + (tid >> 2)) * NPROJ + (tid & 3) * 8); if (TYPE == 1) pwc = gaWCOL[g0 + cn * 128 + (tid >> 2)];
        }
        bf16x8 qa[8];
#pragma unroll
        for (int kk = 0; kk < 8; ++kk) qa[kk] = qn[kk];
#pragma unroll
        for (int kk = 0; kk < 8; ++kk) qn[kk] = *(const bf16x8*)(qsrc + (size_t)(tn + 16 * w + fr) * qpitch + kk * 32 + fq * 8);
        __syncthreads();
        f32x4 Oi[NE];
#pragma unroll
        for (int e = 0; e < NE; ++e) Oi[e] = (f32x4){0.f, 0.f, 0.f, 0.f};
#pragma unroll
        for (int kk = 0; kk < 8; ++kk) {
#pragma unroll
            for (int e = 0; e < NE; ++e) { const bf16x8 br = *(const LAS bf16x8*)(RT + (16 * e + fr) * MX_RP + kk * 32 + fq * 8); Oi[e] = MFMA16(qa[kk], br, Oi[e]); }
        }
#pragma unroll
        for (int p = 0; p < 2; ++p) {
#pragma unroll
            for (int k = 0; k < 4; ++k) *(LAS u32x4*)(KP + ((lane >> 1) + 32 * k) * 16 + (lane & 1) * 8) = kb[p][k];
#pragma unroll
            for (int k = 0; k < 4; ++k) kb[p][k] = *(const u32x4*)(ksrc + (size_t)(tn + (lane >> 1) + 32 * k) * qpitch + p * 128 + 16 * w + (lane & 1) * 8);
            LDS_WAIT(); asm volatile("" ::: "memory");
#pragma unroll
            for (int e = 0; e < NE; ++e) St[p][e] = St[p][e] * decay;
#pragma unroll
            for (int ks = 0; ks < 4; ++ks) {
                bf16x8 bg;
#pragma unroll
                for (int i = 0; i < 8; ++i) bg[i] = (short)KP[(ks * 32 + fq * 8 + i) * 16 + fr];
#pragma unroll
                for (int e = 0; e < NE; ++e) { const bf16x8 af = *(const LAS bf16x8*)(V1 + (16 * e + fr) * MX_P + ks * 32 + fq * 8); St[p][e] = MFMA16(af, bg, St[p][e]); }
            }
            LDS_WAIT(); asm volatile("" ::: "memory");
        }
#pragma unroll
        for (int p = 0; p < 2; ++p)
#pragma unroll
            for (int e = 0; e < NE; ++e)
#pragma unroll
                for (int jj = 0; jj < 4; ++jj) RTn[(16 * e + fq * 4 + jj) * MX_RP + p * 128 + 16 * w + fr] = (bf16_t)f2bf(St[p][e][jj]);
#pragma unroll
        for (int jj = 0; jj < 4; ++jj) {
#pragma unroll
            for (int e = 0; e < 2; ++e) KP[(fq * 4 + jj) * 40 + 16 * e + fr] = (bf16_t)f2bf(Oi[e][jj] * wq4[jj]);
            if (TYPE == 1 && sl == 0 && fr == 0) denE[g0 + c * 128 + 16 * w + fq * 4 + jj] = Oi[NE - 1][jj] * wq4[jj];
        }
        LDS_WAIT(); asm volatile("" ::: "memory");
        {
            const u32x4 ov = *(const LAS u32x4*)(KP + (lane >> 2) * 40 + (lane & 3) * 8);
            *(u32x4*)(mixE + (size_t)(t0 + 16 * w + (lane >> 2)) * DM + TYPE * 1024 + h * 256 + sl * 32 + (lane & 3) * 8) = ov;
        }
        LDS_WAIT(); asm volatile("" ::: "memory");
    }
    __syncthreads();
}

constexpr int IN_VT = 69632, IN_ARR = IN_VT + 272 * MX_P * 2;
static_assert(IN_ARR + 1024 <= LDS_BYTES - 64, "intra LDS");
__device__ __forceinline__ void intra_s_piece(f32x4 (&S)[8], const LAS bf16_t* QS, const LAS bf16_t* KS, int w, int fr, int fq) {
#pragma unroll 2
    for (int kk = 0; kk < 4; ++kk) {
        const bf16x8 af = *(const LAS bf16x8*)(QS + (16 * w + fr) * 136 + kk * 32 + fq * 8);
        bf16x8 bq[4];
#pragma unroll
        for (int n = 0; n < 4; ++n) bq[n] = *(const LAS bf16x8*)(KS + (16 * n + fr) * 136 + kk * 32 + fq * 8);
#pragma unroll
        for (int n = 0; n < 4; ++n) S[n] = MFMA16(af, bq[n], S[n]);
        if (w >= 4) {
#pragma unroll
            for (int n = 0; n < 4; ++n) bq[n] = *(const LAS bf16x8*)(KS + (16 * (n + 4) + fr) * 136 + kk * 32 + fq * 8);
#pragma unroll
            for (int n = 0; n < 4; ++n) S[n + 4] = MFMA16(af, bq[n], S[n + 4]);
        }
    }
}

template <int TYPE>
__device__ __forceinline__ void intra_item(LAS unsigned char* lds, const bf16_t* proj, const bf16_t* cq, const float* gaROWL, const float* gaCOLL,
                                           bf16_t* mixI, float* denI, int b, int h, int c) {
    const int tid = threadIdx.x, lane = tid & 63, w = __builtin_amdgcn_readfirstlane(tid >> 6), fr = lane & 15, fq = lane >> 4;
    LAS bf16_t* QS = (LAS bf16_t*)(lds + MX_QS); LAS bf16_t* KS = (LAS bf16_t*)(lds + MX_KS); LAS bf16_t* VT = (LAS bf16_t*)(lds + IN_VT);
    LAS float* rowl = (LAS float*)(lds + IN_ARR); LAS float* coll = rowl + 128;
    const bf16_t* qsrc = TYPE ? cq + h * 256 : proj + h * 256;
    const bf16_t* ksrc = TYPE ? cq + 1024 + h * 256 : proj + 1024 + h * 256;
    const int qpitch = TYPE ? DM : NPROJ;
    const bf16_t* vsrc = proj + (TYPE ? 6144 + h * 256 : 2048 + h * 256);
    const int t0 = b * SEQ_T + c * 128, g0 = (b * 4 + h) * SEQ_T + c * 128;
    const int cv = tid & 15, rb = tid >> 4;
    if (tid < 128) {
        if (TYPE == 1) { rowl[tid] = gaROWL[g0 + tid]; coll[tid] = gaCOLL[g0 + tid]; }
        else { const float lg2 = log2f(1.0f - exp2f(-5.0f - (float)h)); rowl[tid] = (float)tid * lg2; coll[tid] = -(float)tid * lg2; }
    }
    {
        u32x4 vv[8]; const int j = tid >> 2, part = tid & 3;
#pragma unroll
        for (int k = 0; k < 8; ++k) vv[k] = *(const u32x4*)(vsrc + (size_t)(t0 + j) * NPROJ + 32 * k + part * 8);
        u32x4 q0[4], k0[4];
#pragma unroll
        for (int k = 0; k < 4; ++k) {
            q0[k] = *(const u32x4*)(qsrc + (size_t)(t0 + rb + 32 * k) * qpitch + cv * 8);
            k0[k] = *(const u32x4*)(ksrc + (size_t)(t0 + rb + 32 * k) * qpitch + cv * 8);
        }
#pragma unroll
        for (int k = 0; k < 8; ++k) {
            const unsigned uu[4] = {vv[k].x, vv[k].y, vv[k].z, vv[k].w};
#pragma unroll
            for (int q = 0; q < 4; ++q) { VT[(32 * k + part * 8 + 2 * q) * MX_P + j] = (bf16_t)(uu[q] & 0xffffu); VT[(32 * k + part * 8 + 2 * q + 1) * MX_P + j] = (bf16_t)(uu[q] >> 16); }
        }
#pragma unroll
        for (int k = 0; k < 4; ++k) { *(LAS u32x4*)(QS + (rb + 32 * k) * MX_P + cv * 8) = q0[k]; *(LAS u32x4*)(KS + (rb + 32 * k) * MX_P + cv * 8) = k0[k]; }
    }
    u32x4 q1[4], k1[4];
#pragma unroll
    for (int k = 0; k < 4; ++k) {
        q1[k] = *(const u32x4*)(qsrc + (size_t)(t0 + rb + 32 * k) * qpitch + 128 + cv * 8);
        k1[k] = *(const u32x4*)(ksrc + (size_t)(t0 + rb + 32 * k) * qpitch + 128 + cv * 8);
    }
    f32x4 S[8];
#pragma unroll
    for (int n = 0; n < 8; ++n) S[n] = (f32x4){0.f, 0.f, 0.f, 0.f};
    __syncthreads();
    intra_s_piece(S, QS, KS, w, fr, fq);
    __syncthreads();
#pragma unroll
    for (int k = 0; k < 4; ++k) { *(LAS u32x4*)(QS + (rb + 32 * k) * MX_P + cv * 8) = q1[k]; *(LAS u32x4*)(KS + (rb + 32 * k) * MX_P + cv * 8) = k1[k]; }
    __syncthreads();
    intra_s_piece(S, QS, KS, w, fr, fq);
    __syncthreads();
#pragma unroll
    for (int g = 0; g < 2; ++g) if (g == 0 || w >= 4) {
#pragma unroll
        for (int jj = 0; jj < 4; ++jj) {
            const int i = 16 * w + fq * 4 + jj; const float rl = rowl[i];
#pragma unroll
            for (int n4 = 0; n4 < 4; ++n4) {
                const int n = 4 * g + n4, j = 16 * n + fr;
                const float ev = S[n][jj] * __builtin_amdgcn_exp2f(rl + coll[j]);
                QS[i * MX_P + j] = (bf16_t)f2bf((j <= i) ? ev : 0.f);
            }
        }
    }
    __syncthreads();
#pragma unroll 1
    for (int half = 0; half < 2; ++half) {
        f32x4 acc[8], accd = {0.f, 0.f, 0.f, 0.f};
#pragma unroll
        for (int t = 0; t < 8; ++t) acc[t] = (f32x4){0.f, 0.f, 0.f, 0.f};
#pragma unroll
        for (int ks = 0; ks < 4; ++ks) if (ks < 2 || w >= 4) {
            const bf16x8 af = *(const LAS bf16x8*)(QS + (16 * w + fr) * MX_P + ks * 32 + fq * 8);
#pragma unroll
            for (int t = 0; t < 8; ++t) { const bf16x8 bfr = *(const LAS bf16x8*)(VT + (16 * (8 * half + t) + fr) * MX_P + ks * 32 + fq * 8); acc[t] = MFMA16(af, bfr, acc[t]); }
            if (TYPE == 1 && half == 1) { const bf16x8 bfr = *(const LAS bf16x8*)(VT + (256 + fr) * MX_P + ks * 32 + fq * 8); accd = MFMA16(af, bfr, accd); }
        }
        LAS bf16_t* OW = KS + w * 16 * MX_P;
#pragma unroll
        for (int jj = 0; jj < 4; ++jj) {
#pragma unroll
            for (int t = 0; t < 8; ++t) OW[(fq * 4 + jj) * MX_P + 16 * t + fr] = (bf16_t)f2bf(acc[t][jj]);
            if (TYPE == 1 && half == 1 && fr == 0) denI[g0 + 16 * w + fq * 4 + jj] = accd[jj];
        }
        LDS_WAIT(); asm volatile("" ::: "memory");
#pragma unroll
        for (int k = 0; k < 4; ++k) {
            const int ch = (lane & 3) + 4 * k;
            const u32x4 ov = *(const LAS u32x4*)(OW + (lane >> 2) * MX_P + ch * 8);
            *(u32x4*)(mixI + (size_t)(t0 + 16 * w + (lane >> 2)) * DM + TYPE * 1024 + h * 256 + 128 * half + ch * 8) = ov;
        }
        LDS_WAIT(); asm volatile("" ::: "memory");
    }
    __syncthreads();
}

struct MixArgs { const bf16_t* proj; const bf16_t* cq; const float* rowl; const float* coll; const float* wq; const float* wcol; const float* dec; bf16_t* mixI; bf16_t* mixE; float* denI; float* denE; };
__device__ __forceinline__ void phase_mixers(LAS unsigned char* lds, const MixArgs& A) {
    for (int item = blockIdx.x; item < 256; item += gridDim.x) {
        const int type = item & 1, rest = item >> 1, bh = rest >> 3, sl = rest & 7, b = bh >> 2, h = bh & 3;
        if (type == 0) inter_item<0>(lds, A.proj, A.cq, A.wq, A.wcol, A.dec, A.mixE, A.denE, b, h, sl);
        else inter_item<1>(lds, A.proj, A.cq, A.wq, A.wcol, A.dec, A.mixE, A.denE, b, h, sl);
    }
    { LAS bf16_t* VT = (LAS bf16_t*)(lds + IN_VT);
      for (int i = threadIdx.x; i < 16 * MX_P; i += 512) VT[256 * MX_P + i] = (i < MX_P) ? (bf16_t)0x3F80 : (bf16_t)0;
      __syncthreads(); }
    for (int item = blockIdx.x; item < 1024; item += gridDim.x) {
        const int type = item & 1, rest = item >> 1, c = rest & 31, bh = rest >> 5, b = bh >> 2, h = bh & 3;
        if (type == 0) intra_item<0>(lds, A.proj, A.cq, A.rowl, A.coll, A.mixI, A.denI, b, h, c);
        else intra_item<1>(lds, A.proj, A.cq, A.rowl, A.coll, A.mixI, A.denI, b, h, c);
    }
}

constexpr int AT_KP = 72, AT_VP = 280, AT_PP = 168;
constexpr int AT_KS = 0, AT_VT = 256 * AT_KP * 2, AT_PW = AT_VT + 64 * AT_VP * 2, AT_BIAS = AT_PW + 8 * 16 * AT_PP * 2, AT_END = AT_BIAS + 8 * 128 * 4;
static_assert(AT_END <= LDS_BYTES, "attention LDS");

__device__ __forceinline__ void phase_attn(LAS unsigned char* lds, const bf16_t* qkv, const float* biasT, const float* sinks, bf16_t* cat) {
    const int tid = threadIdx.x, lane = tid & 63, w = __builtin_amdgcn_readfirstlane(tid >> 6), fr = lane & 15, fq = lane >> 4;
    LAS bf16_t* KS = (LAS bf16_t*)(lds + AT_KS); LAS bf16_t* VT = (LAS bf16_t*)(lds + AT_VT);
    LAS bf16_t* PW = (LAS bf16_t*)(lds + AT_PW) + w * 16 * AT_PP; LAS float* BS = (LAS float*)(lds + AT_BIAS);
    for (int item = blockIdx.x; item < 512; item += gridDim.x) {
        const int kvh = item & 3, n = (item >> 2) & 31, b = item >> 7;
        const int tok0 = b * SEQ_T + n * 128;
        const int hq = kvh * 8 + w;
        bf16x8 qf[8][2];
#pragma unroll
        for (int it = 0; it < 8; ++it) {
            const bf16_t* qp = qkv + (size_t)(tok0 + 16 * it + fr) * NQKV + hq * 64 + fq * 8;
            qf[it][0] = __builtin_nontemporal_load((const bf16x8*)qp); qf[it][1] = __builtin_nontemporal_load((const bf16x8*)(qp + 32));
        }
        float bval[9][4];
#pragma unroll
        for (int t = 0; t < 9; ++t)
#pragma unroll
            for (int jj = 0; jj < 4; ++jj) {
                const int dist = 128 + fq * 4 + jj - 16 * t - fr;
                bval[t][jj] = (dist >= 0 && dist < 128) ? biasT[hq * 128 + (dist & 127)] : -INFINITY;
            }
#pragma unroll
        for (int k = 0; k < 4; ++k) {
            const int j = (tid >> 3) + 64 * k, cv = tid & 7;
            const int pos = n * 128 - 128 + j;
            u32x4 kk = {0u, 0u, 0u, 0u}, vv = {0u, 0u, 0u, 0u};
            if (pos >= 0) {
                const bf16_t* rp = qkv + (size_t)(b * SEQ_T + pos) * NQKV + kvh * 64 + cv * 8;
                kk = *(const u32x4*)(rp + 2048); vv = *(const u32x4*)(rp + 2304);
            }
            *(LAS u32x4*)(KS + j * AT_KP + cv * 8) = kk;
            const unsigned uu[4] = {vv.x, vv.y, vv.z, vv.w};
#pragma unroll
            for (int q = 0; q < 4; ++q) { VT[(cv * 8 + 2 * q) * AT_VP + j] = (bf16_t)(uu[q] & 0xffffu); VT[(cv * 8 + 2 * q + 1) * AT_VP + j] = (bf16_t)(uu[q] >> 16); }
        }
        for (int i = tid; i < 64 * 16; i += 512) VT[(i >> 4) * AT_VP + 256 + (i & 15)] = 0;
        __syncthreads();
        const float sink = sinks[hq];
#pragma unroll
        for (int it = 0; it < 8; ++it) {
            const bf16x8 q0 = qf[it][0], q1 = qf[it][1];
            f32x4 S[9];
#pragma unroll
            for (int t = 0; t < 9; ++t) {
                S[t] = (f32x4){0.f, 0.f, 0.f, 0.f};
                const LAS bf16_t* kp = KS + (16 * (it + t) + fr) * AT_KP + fq * 8;
                S[t] = MFMA16(q0, *(const LAS bf16x8*)kp, S[t]);
                S[t] = MFMA16(q1, *(const LAS bf16x8*)(kp + 32), S[t]);
            }
            float mx[4], sm[4];
#pragma unroll
            for (int jj = 0; jj < 4; ++jj) mx[jj] = -INFINITY;
#pragma unroll
            for (int t = 0; t < 9; ++t) {
                const bool cut = (n == 0) && (it + t < 8);
#pragma unroll
                for (int jj = 0; jj < 4; ++jj) {
                    float sv = fmaf(S[t][jj], 0.125f, bval[t][jj]);
                    if (cut) sv = -INFINITY;
                    S[t][jj] = sv; mx[jj] = fmaxf(mx[jj], sv);
                }
            }
#pragma unroll
            for (int jj = 0; jj < 4; ++jj) mx[jj] = fmaxf(row_max16(mx[jj]), sink);
#pragma unroll
            for (int jj = 0; jj < 4; ++jj) sm[jj] = 0.f;
#pragma unroll
            for (int t = 0; t < 9; ++t)
#pragma unroll
                for (int jj = 0; jj < 4; ++jj) { const float pv = __expf(S[t][jj] - mx[jj]); S[t][jj] = pv; sm[jj] += pv; }
#pragma unroll
            for (int jj = 0; jj < 4; ++jj) sm[jj] = row_sum16(sm[jj]) + __expf(sink - mx[jj]);
#pragma unroll
            for (int jj = 0; jj < 4; ++jj) {
#pragma unroll
                for (int t = 0; t < 9; ++t) PW[(fq * 4 + jj) * AT_PP + 16 * t + fr] = (bf16_t)f2bf(S[t][jj]);
                PW[(fq * 4 + jj) * AT_PP + 144 + fr] = 0;
            }
            LDS_WAIT(); asm volatile("" ::: "memory");
            f32x4 O[4];
#pragma unroll
            for (int e = 0; e < 4; ++e) O[e] = (f32x4){0.f, 0.f, 0.f, 0.f};
#pragma unroll
            for (int ks = 0; ks < 5; ++ks) {
                const bf16x8 af = *(const LAS bf16x8*)(PW + fr * AT_PP + ks * 32 + fq * 8);
#pragma unroll
                for (int e = 0; e < 4; ++e) { const bf16x8 bfr = *(const LAS bf16x8*)(VT + (16 * e + fr) * AT_VP + 16 * it + ks * 32 + fq * 8); O[e] = MFMA16(af, bfr, O[e]); }
            }
            LDS_WAIT(); asm volatile("" ::: "memory");
#pragma unroll
            for (int jj = 0; jj < 4; ++jj) {
                const float inv = 1.0f / sm[jj];
#pragma unroll
                for (int e = 0; e < 4; ++e) PW[(fq * 4 + jj) * AT_PP + 16 * e + fr] = (bf16_t)f2bf(O[e][jj] * inv);
            }
            LDS_WAIT(); asm volatile("" ::: "memory");
#pragma unroll
            for (int k = 0; k < 2; ++k) {
                const int ch = (lane & 3) + 4 * k;
                const u32x4 ov = *(const LAS u32x4*)(PW + (lane >> 2) * AT_PP + ch * 8);
                *(u32x4*)(cat + (size_t)(tok0 + 16 * it + (lane >> 2)) * DM + hq * 64 + ch * 8) = ov;
            }
            LDS_WAIT(); asm volatile("" ::: "memory");
        }
        __syncthreads();
    }
}

#define XB_TMO      128
#define XB_XCNT(j)  (256  + 64 * (j))
#define XB_XSUB(j)  (1280 + 64 * (j))
#define XB_XGEN(j)  (2304 + 64 * (j))
#define XB_TOP      3328
#define XB_TOPGEN   3392
#define XCD_BAR_WORDS 3456
#define XB_SPIN_CAP (1u << 22)
__device__ __forceinline__ unsigned xb_ld(unsigned* p)              { return __hip_atomic_load(p, __ATOMIC_RELAXED, __HIP_MEMORY_SCOPE_AGENT); }
__device__ __forceinline__ unsigned xb_add(unsigned* p, unsigned v) { return __hip_atomic_fetch_add(p, v, __ATOMIC_RELAXED, __HIP_MEMORY_SCOPE_AGENT); }
__device__ __forceinline__ unsigned xb_xcc_id() { return (unsigned)__builtin_amdgcn_s_getreg((3 << 11) | 20) & 0xFu; }
#define XB_SPIN(cond, bar) do { unsigned _sp = 0; while (cond) { __builtin_amdgcn_s_sleep(1); \
    if ((++_sp & 255u) == 0u) { if (xb_ld(&(bar)[XB_TMO])) break; if (_sp > XB_SPIN_CAP) { atomicAdd(&(bar)[XB_TMO], 1u); break; } } } } while (0)
struct XcdBarrier { unsigned* bar; unsigned x; volatile LAS unsigned* st; };
__device__ __forceinline__ XcdBarrier xcd_barrier_post(unsigned* bar, volatile LAS unsigned* st) {
    XcdBarrier b; b.bar = bar; b.x = xb_xcc_id(); b.st = st;
    if (threadIdx.x == 0) (void)xb_add(&bar[XB_XCNT(b.x)], 1u);
    return b;
}
__device__ __forceinline__ void xcd_barrier_complete(unsigned* bar, unsigned x, unsigned& nloc, unsigned& nx) {
    const unsigned G = gridDim.x * gridDim.y * gridDim.z;
    unsigned sum, cnt, mine, sp = 0u;
    for (;;) {
        sum = 0u; cnt = 0u; mine = 0u;
#pragma unroll
        for (unsigned j = 0; j < 16; ++j) { const unsigned c = xb_ld(&bar[XB_XCNT(j)]); sum += c; cnt += (c > 0u) ? 1u : 0u; mine = (j == x) ? c : mine; }
        if (sum == G) break;
        __builtin_amdgcn_s_sleep(1);
        if ((++sp & 255u) == 0u) { if (xb_ld(&bar[XB_TMO])) break; if (sp > XB_SPIN_CAP) { atomicAdd(&bar[XB_TMO], 1u); break; } }
    }
    nloc = mine > 0u ? mine : 1u; nx = cnt > 0u ? cnt : 1u;
}
__device__ __forceinline__ void xcd_barrier(const XcdBarrier& b) {
    asm volatile("s_waitcnt vmcnt(0)" ::: "memory");
    __syncthreads();
    if (threadIdx.x == 0) {
        unsigned* bar = b.bar;
        __builtin_amdgcn_s_waitcnt(0);
        unsigned nloc = b.st[0], nx = b.st[1];
        if (nloc == 0u) { xcd_barrier_complete(bar, b.x, nloc, nx); b.st[0] = nloc; b.st[1] = nx; }
        const unsigned old = xb_add(&bar[XB_XSUB(b.x)], 1u);
        const unsigned gen = old / nloc;
        if (old + 1u == (gen + 1u) * nloc) {
            __builtin_amdgcn_fence(__ATOMIC_RELEASE, "agent");
            asm volatile("s_waitcnt vmcnt(0)" ::: "memory");
            const unsigned og = xb_add(&bar[XB_TOP], 1u);
            const unsigned tg = og / nx;
            if (og + 1u == (tg + 1u) * nx) xb_add(&bar[XB_TOPGEN], 1u);
            else XB_SPIN(xb_ld(&bar[XB_TOPGEN]) == tg, bar);
            __builtin_amdgcn_fence(__ATOMIC_ACQUIRE, "agent");
            xb_add(&bar[XB_XGEN(b.x)], 1u);
            asm volatile("s_waitcnt vmcnt(0)" ::: "memory");
        } else {
            XB_SPIN(xb_ld(&bar[XB_XGEN(b.x)]) == gen, bar);
            __builtin_amdgcn_fence(__ATOMIC_ACQUIRE, "agent");
            asm volatile("s_waitcnt vmcnt(0)" ::: "memory");
        }
    }
    __syncthreads();
}

__global__ void __launch_bounds__(512, 2) fwd_kernel(Args args) {
    extern __shared__ __attribute__((aligned(16))) unsigned char lds_raw[];
    LAS unsigned char* lds = (LAS unsigned char*)lds_raw;
    cg::grid_group grid = cg::this_grid();
    unsigned char* ws = args.ws;
    const int lo = args.ph_lo, hi = args.ph_hi;
#define IN(k) (lo <= (k) && (k) < hi)
    volatile LAS unsigned* bst = (volatile LAS unsigned*)(lds + LDS_BYTES - 64);
    if (threadIdx.x < 2) bst[threadIdx.x] = 0u;
    __syncthreads();
    const XcdBarrier xbar = xcd_barrier_post((unsigned*)(ws + OFF_CTL), bst);
#define SEAM(k) do { if (IN(k) && IN((k) + 1)) { if ((k) == 0) grid.sync(); else xcd_barrier(xbar); } } while (0)
    const float* x = args.in[0];
    const float* norm_g = args.in[2];
    float* out = args.out;
    bf16_t* bufA = (bf16_t*)(ws + OFF_A);
    float* bufY = (float*)(ws + OFF_Y);
    bf16_t* bufH = (bf16_t*)(ws + OFF_H);
    const int G = gridDim.x, cidx = blockIdx.x;

    if (IN(0)) phase_prologue(lds, args);
    SEAM(0);
    if (IN(1)) {
        pg8::Gemm g{bufH, (const bf16_t*)(ws + OFF_WIN), M_TOK, NPROJ, DM}; pg8::StaticOrder S; S.init(M_TOK, NPROJ, G, cidx);
        EpiProj0 E{bufA, (const float*)(ws + OFF_COS), (const float*)(ws + OFF_SIN)};
        pg8::gemm_phase<EpiProj0, pg8::StaticOrder, true, true>(lds, g, S, E);
    }
    SEAM(1);
    const GateArrays GA{(float*)(ws + OFF_GA_ROWL), (float*)(ws + OFF_GA_COLL), (float*)(ws + OFF_GA_WQ), (float*)(ws + OFF_GA_WCOL), (float*)(ws + OFF_GA_FLR), (float*)(ws + OFF_GA_DEC)};
    bf16_t* mixI = (bf16_t*)bufY; bf16_t* mixE = (bf16_t*)bufY + (size_t)M_TOK * DM;
    bf16_t* xs = mixE;
    if (IN(2)) {
        phase_conv(bufA, args.in[6], bufH, (const float*)(ws + OFF_GATES), GA);
        xcd_barrier(xbar);
        const MixArgs MA{bufA, bufH, GA.rowl, GA.coll, GA.wq, GA.wcol, GA.dec, mixI, mixE, (float*)(ws + OFF_DENI), (float*)(ws + OFF_DENE)};
        phase_mixers(lds, MA);
    }
    SEAM(2);
    if (IN(3)) phase_combine(mixI, mixE, (const float*)(ws + OFF_DENI), (const float*)(ws + OFF_DENE), GA.flr, bufA, args.in[8], bufH);
    SEAM(3);
    if (IN(4)) {
        pg8::Gemm g{bufH, (const bf16_t*)(ws + OFF_WOUT0), M_TOK, DM, DM}; pg8::StaticOrder S; S.init(M_TOK, DM, G, cidx);
        EpiBf16 E{(bf16_t*)bufY, DM};
        pg8::gemm_phase<EpiBf16, pg8::StaticOrder, true, true>(lds, g, S, E);
    }
    SEAM(4);
    if (IN(5)) phase_normres<false, true>(x, xs, (const bf16_t*)bufY, norm_g + 1 * DM, norm_g + 2 * DM, bufH);
    SEAM(5);
    if (IN(6)) {
        pg8::Gemm g{bufH, (const bf16_t*)(ws + OFF_WGU0), M_TOK, 2 * FF, DM}; pg8::StaticOrder S; S.init(M_TOK, 2 * FF, G, cidx);
        EpiSwiGLU E{bufA};
        pg8::gemm_phase<EpiSwiGLU, pg8::StaticOrder, true, true>(lds, g, S, E);
    }
    SEAM(6);
    if (IN(7)) {
        pg8::Gemm g{bufA, (const bf16_t*)(ws + OFF_WD0), M_TOK, DM, FF}; pg8::StaticOrder S; S.init(M_TOK, DM, G, cidx);
        EpiBf16 E{(bf16_t*)bufY, DM};
        pg8::gemm_phase<EpiBf16, pg8::StaticOrder, true, true>(lds, g, S, E);
    }
    SEAM(7);
    if (IN(8)) phase_normres<true, true>(xs, xs, (const bf16_t*)bufY, norm_g + 3 * DM, norm_g + 4 * DM, bufH);
    SEAM(8);
    if (IN(9)) {
        pg8::Gemm g{bufH, (const bf16_t*)(ws + OFF_WSWA), M_TOK, NQKV, DM}; pg8::StaticOrder S; S.init(M_TOK, NQKV, G, cidx);
        EpiBf16 E{bufA, NQKV};
        pg8::gemm_phase<EpiBf16, pg8::StaticOrder, true, true>(lds, g, S, E);
    }
    SEAM(9);
    if (IN(10)) phase_attn(lds, bufA, (const float*)(ws + OFF_BIAS), args.in[11], bufH);
    SEAM(10);
    if (IN(11)) {
        pg8::Gemm g{bufH, (const bf16_t*)(ws + OFF_WO1), M_TOK, DM, DM}; pg8::StaticOrder S; S.init(M_TOK, DM, G, cidx);
        EpiBf16 E{(bf16_t*)bufY, DM};
        pg8::gemm_phase<EpiBf16, pg8::StaticOrder, true, true>(lds, g, S, E);
    }
    SEAM(11);
    if (IN(12)) phase_normres<true, true>(xs, xs, (const bf16_t*)bufY, norm_g + 5 * DM, norm_g + 6 * DM, bufH);
    SEAM(12);
    if (IN(13)) {
        pg8::Gemm g{bufH, (const bf16_t*)(ws + OFF_WGU1), M_TOK, 2 * FF, DM}; pg8::StaticOrder S; S.init(M_TOK, 2 * FF, G, cidx);
        EpiSwiGLU E{bufA};
        pg8::gemm_phase<EpiSwiGLU, pg8::StaticOrder, true, true>(lds, g, S, E);
    }
    SEAM(13);
    if (IN(14)) {
        pg8::Gemm g{bufA, (const bf16_t*)(ws + OFF_WD1), M_TOK, DM, FF}; pg8::StaticOrder S; S.init(M_TOK, DM, G, cidx);
        EpiBf16 E{(bf16_t*)bufY, DM};
        pg8::gemm_phase<EpiBf16, pg8::StaticOrder, true, true>(lds, g, S, E);
    }
    SEAM(14);
    if (IN(15)) phase_normres<true, false>(xs, out, (const bf16_t*)bufY, norm_g + 7 * DM, nullptr, bufH);
}

extern "C" void kernel_launch(void* const* d_in, const int* in_sizes, int n_in, void* d_out, int out_size, void* d_ws, size_t ws_size, hipStream_t stream) {
    static int grid = 0;
    if (grid == 0) {
        if (n_in != 13 || ws_size < WS_END) { fprintf(stderr, "kernel_launch: unexpected n_in %d / ws %zu (need %zu)\n", n_in, ws_size, (size_t)WS_END); grid = -1; return; }
        int dev = 0, cus = 0, per_cu = 0;
        hipGetDevice(&dev);
        hipDeviceGetAttribute(&cus, hipDeviceAttributeMultiprocessorCount, dev);
        if (hipFuncSetAttribute((const void*)fwd_kernel, hipFuncAttributeMaxDynamicSharedMemorySize, LDS_BYTES) != hipSuccess) { fprintf(stderr, "kernel_launch: hipFuncSetAttribute failed\n"); grid = -1; return; }
        if (hipOccupancyMaxActiveBlocksPerMultiprocessor(&per_cu, (const void*)fwd_kernel, 512, LDS_BYTES) != hipSuccess || per_cu < 1) { fprintf(stderr, "kernel_launch: occupancy query says %d\n", per_cu); per_cu = 1; }
        (void)hipGetLastError();
        grid = cus * per_cu;
    }
    if (grid < 0) return;
    if (hipMemsetAsync((char*)d_ws + OFF_CTL, 0, CTL_BYTES, stream) != hipSuccess) { fprintf(stderr, "kernel_launch: memset of barrier words failed\n"); return; }
    Args a{};
    for (int i = 0; i < 13; ++i) a.in[i] = (const float*)d_in[i];
    a.out = (float*)d_out; a.ws = (unsigned char*)d_ws; a.ph_lo = 0; a.ph_hi = 16;
    void* kargs[] = {&a};
    hipError_t e = hipLaunchCooperativeKernel((const void*)fwd_kernel, dim3(grid), dim3(512), kargs, LDS_BYTES, stream);
    if (e != hipSuccess) fprintf(stderr, "cooperative launch failed: %s (grid %d)\n", hipGetErrorString(e), grid);
}
```

```cpp
#include <hip/hip_runtime.h>
#include <hip/hip_cooperative_groups.h>
#include <cstdio>
#include <cstdint>
namespace cg = cooperative_groups;

#define LAS __attribute__((address_space(3)))
typedef unsigned short bf16_t;
typedef short bf16x8 __attribute__((ext_vector_type(8)));
typedef float f32x4 __attribute__((ext_vector_type(4)));
typedef unsigned u32x4 __attribute__((ext_vector_type(4)));
typedef unsigned u32x2 __attribute__((ext_vector_type(2)));

namespace pg8 {
#define PG8_LAS __attribute__((address_space(3)))
constexpr int BM = 256, BK = 64, HALF = 128, HTB = HALF * BK * 2, STAGE_BYTES = 8 * HTB, NXCD = 8, WGM = 8;

__host__ __device__ __forceinline__ int lds_byte(int r, int c) { const int st = (r >> 4) * 2 + (c >> 5), rr = r & 15, cc = c & 31, ob = rr * 64 + cc * 2; return st * 1024 + (ob ^ (((ob >> 9) & 1) << 5)); }
__host__ __device__ __forceinline__ void stage_rc(int b, int& R, int& C) { const int st = b / 1024, sb = b % 1024, swz = sb ^ (((sb >> 9) & 1) << 5); R = (st >> 1) * 16 + swz / 64; C = (st & 1) * 32 + (swz % 64) / 2; }
__host__ __device__ __forceinline__ int perm32(int rho) { const int n = rho >> 4, i = rho & 15; return 8 * (i >> 2) + 4 * n + (i & 3); }

struct Unit { int pm, pn; };
struct Gemm { const bf16_t* A; const bf16_t* Bt; int M, N, K; };

struct StaticOrder {
    int nM, nN, nwg, G, c;
    __host__ __device__ void init(int M, int N, int G_, int c_) { nM = M / BM; nN = N / BM; nwg = nM * nN; G = G_; c = c_; }
    __host__ __device__ bool next(int i, Unit& u) const {
        const long L = (long)i * G + c; if (L >= nwg) return false;
        int wgid = (int)L; { const int q = nwg / NXCD, r = nwg % NXCD, xcd = wgid % NXCD, off = wgid / NXCD; wgid = (xcd < r ? xcd * (q + 1) : r * (q + 1) + (xcd - r) * q) + off; }
        const int nig = WGM * nN, gid = wgid / nig, fm = gid * WGM, gsz = (nM - fm) < WGM ? (nM - fm) : WGM;
        u.pm = fm + ((wgid % nig) % gsz); u.pn = (wgid % nig) / gsz; return true;
    }
    __device__ __forceinline__ void a_ready(const Unit&) const {}
    __device__ __forceinline__ void done(const Unit&) const {}
};

__device__ __forceinline__ unsigned cvt_pk_bf16(float lo, float hi) { unsigned r; asm volatile("v_cvt_pk_bf16_f32 %0, %1, %2" : "=v"(r) : "v"(lo), "v"(hi)); return r; }

template <class Epi, class Sched, bool ALIGN_EPI = false, bool SP2 = false>
__device__ __forceinline__ void gemm_phase(PG8_LAS unsigned char* lds, const Gemm g, const Sched& S, const Epi& E) {
    const int tid = threadIdx.x, wid = __builtin_amdgcn_readfirstlane(tid >> 6), lane = tid & 63, wr = wid >> 2, wc = wid & 3, fr = lane & 15, fq = lane >> 4;
    const int K = g.K, nt = K / BK;
    unsigned voffA[2], voffB[2];
#pragma unroll
    for (int i = 0; i < 2; ++i) { int R, C; stage_rc(tid * 16 + i * 8192, R, C); const int Rb = Epi::PERM ? ((R & ~31) + perm32(R & 31)) : R;
        voffA[i] = (unsigned)(R * K + C) * 2u; voffB[i] = (unsigned)(Rb * K + C) * 2u; }
    const size_t kstep = (size_t)(BK * 2);
    const size_t hstep = (size_t)HALF * K * 2;
    const size_t tstep = 2 * hstep;
    const unsigned ldsw = (unsigned)wid * 1024u;
    const int aoff = lds_byte(wr * 64 + fr, fq * 8), boff = lds_byte(wc * 32 + fr, fq * 8);
#define PG8_SA(b, h) (((b) * 2 + (h)) * HTB)
#define PG8_SB(b, h) ((4 + (b) * 2 + (h)) * HTB)
#define PG8_STAGE(bufoff, gbase, voff) do { _Pragma("unroll") for (int _i = 0; _i < 2; ++_i) \
        __builtin_amdgcn_global_load_lds((const unsigned*)((const char*)(gbase) + (voff)[_i]), (PG8_LAS unsigned*)(lds + (bufoff) + ldsw + _i * 8192), 16, 0, 0); } while (0)
#define PG8_LDA(dst, b, h) do { _Pragma("unroll") for (int m = 0; m < 4; ++m) _Pragma("unroll") for (int k = 0; k < 2; ++k) dst[m][k] = *(const PG8_LAS bf16x8*)(lds + PG8_SA(b, h) + aoff + m * 2048 + k * 1024); } while (0)
#define PG8_LDB(dst, b, h) do { _Pragma("unroll") for (int n = 0; n < 2; ++n) _Pragma("unroll") for (int k = 0; k < 2; ++k) dst[n][k] = *(const PG8_LAS bf16x8*)(lds + PG8_SB(b, h) + boff + n * 2048 + k * 1024); } while (0)
#define PG8_MMA(ai, bj, At, Bt) do { __builtin_amdgcn_s_setprio(1); _Pragma("unroll") for (int m = 0; m < 4; ++m) _Pragma("unroll") for (int n = 0; n < 2; ++n) _Pragma("unroll") for (int k = 0; k < 2; ++k) \
        acc[ai][bj][m][n] = __builtin_amdgcn_mfma_f32_16x16x32_bf16(Bt[n][k], At[m][k], acc[ai][bj][m][n], 0, 0, 0); __builtin_amdgcn_s_setprio(0); } while (0)
#define PG8_WAIT_V(n) asm volatile("s_waitcnt vmcnt(" #n ")" ::: "memory")
#define PG8_WAIT_L(n) asm volatile("s_waitcnt lgkmcnt(" #n ")" ::: "memory")
#define PG8_BAR __builtin_amdgcn_s_barrier()
#define PG8_SCHED __builtin_amdgcn_sched_barrier(0)
    Unit cur, nxt; int ui = 0;
    if (!S.next(0, cur)) return;
    f32x4 acc[2][2][4][2];
#pragma unroll
    for (int a = 0; a < 2; ++a)
#pragma unroll
        for (int b = 0; b < 2; ++b)
#pragma unroll
            for (int m = 0; m < 4; ++m)
#pragma unroll
                for (int n = 0; n < 2; ++n) acc[a][b][m][n] = (f32x4){0.f, 0.f, 0.f, 0.f};
    bf16x8 At[4][2], B0[2][2], B1[2][2];
    const char* cA = (const char*)g.A + (size_t)cur.pm * tstep; const char* cB = (const char*)g.Bt + (size_t)cur.pn * tstep;
    S.a_ready(cur);
    if constexpr (SP2) {
        PG8_STAGE(PG8_SB(0, 0), cB, voffB); PG8_STAGE(PG8_SB(0, 1), cB + hstep, voffB); PG8_STAGE(PG8_SA(0, 0), cA, voffA); PG8_STAGE(PG8_SA(0, 1), cA + hstep, voffA);
        if (wr == 1) PG8_BAR;
        PG8_WAIT_V(2); PG8_BAR;
        PG8_STAGE(PG8_SB(1, 0), cB + kstep, voffB); PG8_STAGE(PG8_SA(1, 0), cA + kstep, voffA); PG8_STAGE(PG8_SB(1, 1), cB + hstep + kstep, voffB);
        PG8_WAIT_V(6); PG8_BAR;
    } else {
        PG8_STAGE(PG8_SB(0, 0), cB, voffB); PG8_STAGE(PG8_SA(0, 0), cA, voffA); PG8_STAGE(PG8_SB(0, 1), cB + hstep, voffB); PG8_STAGE(PG8_SA(0, 1), cA + hstep, voffA);
        if (wr == 1) PG8_BAR;
        PG8_WAIT_V(4); PG8_BAR;
        PG8_STAGE(PG8_SB(1, 0), cB + kstep, voffB); PG8_STAGE(PG8_SA(1, 0), cA + kstep, voffA); PG8_STAGE(PG8_SB(1, 1), cB + hstep + kstep, voffB);
        PG8_WAIT_V(6); PG8_BAR;
    }
    for (;;) {
        const bool has_next = S.next(ui + 1, nxt);
        const char* nA = has_next ? (const char*)g.A + (size_t)nxt.pm * tstep : cA; const char* nB = has_next ? (const char*)g.Bt + (size_t)nxt.pn * tstep : cB;
        for (int t = 0; t < nt; t += 2) {
            const bool last = (t == nt - 2);
            const char* a1 = cA + (size_t)(t + 1) * kstep;
            const char* a2 = last ? nA : cA + (size_t)(t + 2) * kstep; const char* b2 = last ? nB : cB + (size_t)(t + 2) * kstep;
            const char* a3 = a2 + kstep; const char* b3 = b2 + kstep;
            if (last && has_next) S.a_ready(nxt);
            if constexpr (SP2) {
            PG8_LDB(B0, 0, 0); PG8_LDB(B1, 0, 1); PG8_SCHED; PG8_LDA(At, 0, 0); PG8_STAGE(PG8_SA(1, 1), a1 + hstep, voffA);
            PG8_WAIT_V(8); PG8_WAIT_L(0); PG8_BAR; PG8_MMA(0, 0, At, B0); PG8_MMA(0, 1, At, B1); PG8_BAR; PG8_SCHED;
            PG8_LDA(At, 0, 1); PG8_STAGE(PG8_SB(0, 0), b2, voffB); PG8_STAGE(PG8_SB(0, 1), b2 + hstep, voffB); PG8_STAGE(PG8_SA(0, 0), a2, voffA);
            PG8_WAIT_V(8); PG8_WAIT_L(0); PG8_BAR; PG8_MMA(1, 0, At, B0); PG8_MMA(1, 1, At, B1); PG8_BAR; PG8_SCHED;
            PG8_LDB(B0, 1, 0); PG8_LDB(B1, 1, 1); PG8_SCHED; PG8_LDA(At, 1, 0); PG8_STAGE(PG8_SA(0, 1), a2 + hstep, voffA);
            PG8_WAIT_V(8); PG8_WAIT_L(0); PG8_BAR; PG8_MMA(0, 0, At, B0); PG8_MMA(0, 1, At, B1); PG8_BAR; PG8_SCHED;
            PG8_LDA(At, 1, 1); PG8_STAGE(PG8_SB(1, 0), b3, voffB); PG8_STAGE(PG8_SB(1, 1), b3 + hstep, voffB); PG8_STAGE(PG8_SA(1, 0), a3, voffA);
            PG8_WAIT_V(8); PG8_WAIT_L(0); PG8_BAR; PG8_MMA(1, 0, At, B0); PG8_MMA(1, 1, At, B1); PG8_BAR; PG8_SCHED;
            } else {
            PG8_LDB(B0, 0, 0); PG8_SCHED; PG8_LDA(At, 0, 0); PG8_STAGE(PG8_SA(1, 1), a1 + hstep, voffA);
            PG8_WAIT_L(8); PG8_BAR; PG8_WAIT_L(0); PG8_MMA(0, 0, At, B0); PG8_BAR; PG8_SCHED;
            PG8_LDB(B1, 0, 1); PG8_STAGE(PG8_SB(0, 0), b2, voffB);
            PG8_BAR; PG8_WAIT_L(0); PG8_MMA(0, 1, At, B1); PG8_BAR;
            PG8_LDA(At, 0, 1); PG8_STAGE(PG8_SA(0, 0), a2, voffA);
            PG8_BAR; PG8_WAIT_L(0); PG8_MMA(1, 0, At, B0); PG8_BAR; PG8_SCHED;
            PG8_STAGE(PG8_SB(0, 1), b2 + hstep, voffB);
            PG8_WAIT_V(6); PG8_BAR; PG8_MMA(1, 1, At, B1); PG8_BAR;
            PG8_LDB(B0, 1, 0); PG8_SCHED; PG8_LDA(At, 1, 0); PG8_STAGE(PG8_SA(0, 1), a2 + hstep, voffA);
            PG8_WAIT_L(8); PG8_BAR; PG8_WAIT_L(0); PG8_MMA(0, 0, At, B0); PG8_BAR; PG8_SCHED;
            PG8_LDB(B1, 1, 1); PG8_STAGE(PG8_SB(1, 0), b3, voffB);
            PG8_BAR; PG8_WAIT_L(0); PG8_MMA(0, 1, At, B1); PG8_BAR;
            PG8_LDA(At, 1, 1); PG8_STAGE(PG8_SA(1, 0), a3, voffA);
            PG8_BAR; PG8_WAIT_L(0); PG8_MMA(1, 0, At, B0); PG8_BAR; PG8_SCHED;
            PG8_STAGE(PG8_SB(1, 1), b3 + hstep, voffB);
            PG8_WAIT_V(6); PG8_BAR; PG8_MMA(1, 1, At, B1); PG8_BAR;
            }
        }
        if constexpr (ALIGN_EPI) { if (wr == 0) PG8_BAR; }
        if constexpr (!Epi::AFTER_DRAIN) { E(acc, cur, wr, wc, fr, fq); S.done(cur); }
        if (!has_next) break;
#pragma unroll
        for (int a = 0; a < 2; ++a)
#pragma unroll
            for (int b = 0; b < 2; ++b)
#pragma unroll
                for (int m = 0; m < 4; ++m)
#pragma unroll
                    for (int n = 0; n < 2; ++n) acc[a][b][m][n] = (f32x4){0.f, 0.f, 0.f, 0.f};
        cur = nxt; cA = nA; cB = nB; ++ui;
        if constexpr (ALIGN_EPI) { if (wr == 1) PG8_BAR; }
    }
    PG8_WAIT_V(0);
    if constexpr (!ALIGN_EPI) { if (wr == 0) PG8_BAR; }
    PG8_BAR;
#undef PG8_SA
#undef PG8_SB
#undef PG8_STAGE
#undef PG8_LDA
#undef PG8_LDB
#undef PG8_MMA
#undef PG8_WAIT_V
#undef PG8_WAIT_L
#undef PG8_BAR
#undef PG8_SCHED
}
}

constexpr int M_TOK = 16384, DM = 2048, SEQ_T = 4096, NPROJ = 8192, RMCOLS = 8200, FF = 5632, NQKV = 2560;
constexpr float EPS = 1e-6f;
constexpr float LOG2E = 1.4426950408889634f;
constexpr int LDS_BYTES = 147456;

constexpr size_t OFF_WIN = 0;
constexpr size_t OFF_WOUT0 = OFF_WIN + (size_t)NPROJ * DM * 2;
constexpr size_t OFF_WGU0 = OFF_WOUT0 + (size_t)DM * DM * 2;
constexpr size_t OFF_WD0 = OFF_WGU0 + (size_t)2 * FF * DM * 2;
constexpr size_t OFF_WSWA = OFF_WD0 + (size_t)DM * FF * 2;
constexpr size_t OFF_WO1 = OFF_WSWA + (size_t)NQKV * DM * 2;
constexpr size_t OFF_WGU1 = OFF_WO1 + (size_t)DM * DM * 2;
constexpr size_t OFF_WD1 = OFF_WGU1 + (size_t)2 * FF * DM * 2;
constexpr size_t OFF_COS = OFF_WD1 + (size_t)DM * FF * 2;
constexpr size_t OFF_SIN = OFF_COS + (size_t)SEQ_T * 128 * 4;
constexpr size_t OFF_GATES = OFF_SIN + (size_t)SEQ_T * 128 * 4;
constexpr size_t OFF_BIAS = OFF_GATES + (size_t)M_TOK * 8 * 4;
constexpr size_t OFF_A = OFF_BIAS + 32 * 128 * 4;
constexpr size_t OFF_Y = OFF_A + (size_t)M_TOK * NPROJ * 2;
constexpr size_t OFF_H = OFF_Y + (size_t)M_TOK * DM * 4;
constexpr size_t OFF_CTL = OFF_H + (size_t)M_TOK * DM * 2;
constexpr size_t CTL_BYTES = 16384;
constexpr size_t GA_BYTES = (size_t)16 * SEQ_T * 4;
constexpr size_t OFF_GA_ROWL = OFF_CTL + CTL_BYTES, OFF_GA_COLL = OFF_GA_ROWL + GA_BYTES, OFF_GA_WQ = OFF_GA_COLL + GA_BYTES, OFF_GA_WCOL = OFF_GA_WQ + GA_BYTES,
                 OFF_GA_FLR = OFF_GA_WCOL + GA_BYTES, OFF_DENI = OFF_GA_FLR + GA_BYTES, OFF_DENE = OFF_DENI + GA_BYTES, OFF_GA_DEC = OFF_DENE + GA_BYTES;
constexpr size_t WS_END = OFF_GA_DEC + 4096;

__device__ __forceinline__ unsigned f2bf(float f) { unsigned u = __builtin_bit_cast(unsigned, f); return (u + 0x7fffu + ((u >> 16) & 1u)) >> 16; }
__device__ __forceinline__ unsigned pk2(float lo, float hi) { return pg8::cvt_pk_bf16(lo, hi); }
__device__ __forceinline__ float bflo(unsigned u) { return __uint_as_float(u << 16); }
__device__ __forceinline__ float bfhi(unsigned u) { return __uint_as_float(u & 0xffff0000u); }
template <int CTRL> __device__ __forceinline__ float dppf(float v) { return __int_as_float(__builtin_amdgcn_update_dpp(0, __float_as_int(v), CTRL, 0xf, 0xf, false)); }
__device__ __forceinline__ float row_max16(float v) { v = fmaxf(v, dppf<0x121>(v)); v = fmaxf(v, dppf<0x122>(v)); v = fmaxf(v, dppf<0x124>(v)); v = fmaxf(v, dppf<0x128>(v)); return v; }
__device__ __forceinline__ float row_sum16(float v) { v += dppf<0x121>(v); v += dppf<0x122>(v); v += dppf<0x124>(v); v += dppf<0x128>(v); return v; }
__device__ __forceinline__ float wave_sum(float v) {
    v = row_sum16(v);
    const int iv = __float_as_int(v);
    const float r0 = __int_as_float(__builtin_amdgcn_readlane(iv, 0)), r1 = __int_as_float(__builtin_amdgcn_readlane(iv, 16));
    const float r2 = __int_as_float(__builtin_amdgcn_readlane(iv, 32)), r3 = __int_as_float(__builtin_amdgcn_readlane(iv, 48));
    return (r0 + r1) + (r2 + r3);
}
__device__ __forceinline__ float siluf(float g) { return g / (1.f + __expf(-g)); }
__device__ __forceinline__ float sigmf(float g) { return 1.f / (1.f + __expf(-g)); }
#define MFMA16(a, b, c) __builtin_amdgcn_mfma_f32_16x16x32_bf16((a), (b), (c), 0, 0, 0)
#define LDS_WAIT() asm volatile("s_waitcnt lgkmcnt(0)" ::: "memory")

struct EpiProj0 {
    static constexpr bool PERM = true, AFTER_DRAIN = false;
    bf16_t* O; const float* cosT; const float* sinT;
    __device__ __forceinline__ void operator()(const f32x4 (&acc)[2][2][4][2], const pg8::Unit& u, int wr, int wc, int fr, int fq) const {
        __builtin_amdgcn_sched_barrier(0); asm volatile("s_nop 7\n\ts_nop 7\n\ts_nop 7" ::: "memory"); __builtin_amdgcn_sched_barrier(0);
        const int grp = u.pn >> 2;
        const int row0 = u.pm * 256 + wr * 64 + fr;
        const int cl = wc * 32 + 8 * fq;
#pragma unroll
        for (int ai = 0; ai < 2; ++ai)
#pragma unroll
            for (int m = 0; m < 4; ++m) {
                const int row = row0 + ai * 128 + m * 16;
                bf16_t* rowp = O + (size_t)row * NPROJ + u.pn * 256 + cl;
                f32x4 v00 = acc[ai][0][m][0], v01 = acc[ai][0][m][1], v10 = acc[ai][1][m][0], v11 = acc[ai][1][m][1];
                if (grp < 2) {
                    const int pos = row & (SEQ_T - 1);
                    const float sc = (grp == 1) ? 0.0625f : 1.0f;
                    const f32x4 c0 = *(const f32x4*)(cosT + pos * 128 + cl), c1 = *(const f32x4*)(cosT + pos * 128 + cl + 4);
                    const f32x4 s0 = *(const f32x4*)(sinT + pos * 128 + cl), s1 = *(const f32x4*)(sinT + pos * 128 + cl + 4);
                    const f32x4 a0 = (v00 * c0 - v10 * s0) * sc, a1 = (v01 * c1 - v11 * s1) * sc;
                    const f32x4 b0 = (v10 * c0 + v00 * s0) * sc, b1 = (v11 * c1 + v01 * s1) * sc;
                    v00 = a0; v01 = a1; v10 = b0; v11 = b1;
                }
                u32x4 w0, w1;
                w0.x = pk2(v00[0], v00[1]); w0.y = pk2(v00[2], v00[3]); w0.z = pk2(v01[0], v01[1]); w0.w = pk2(v01[2], v01[3]);
                w1.x = pk2(v10[0], v10[1]); w1.y = pk2(v10[2], v10[3]); w1.z = pk2(v11[0], v11[1]); w1.w = pk2(v11[2], v11[3]);
                *(u32x4*)(rowp) = w0;
                *(u32x4*)(rowp + 128) = w1;
            }
    }
};
struct EpiBf16 {
    static constexpr bool PERM = true, AFTER_DRAIN = false;
    bf16_t* O; int ldc;
    __device__ __forceinline__ void operator()(const f32x4 (&acc)[2][2][4][2], const pg8::Unit& u, int wr, int wc, int fr, int fq) const {
        __builtin_amdgcn_sched_barrier(0); asm volatile("s_nop 7\n\ts_nop 7\n\ts_nop 7" ::: "memory"); __builtin_amdgcn_sched_barrier(0);
        const int row0 = u.pm * 256 + wr * 64 + fr;
        const int col0 = u.pn * 256 + wc * 32 + 8 * fq;
#pragma unroll
        for (int ai = 0; ai < 2; ++ai)
#pragma unroll
            for (int m = 0; m < 4; ++m) {
                bf16_t* rowp = O + (size_t)(row0 + ai * 128 + m * 16) * ldc + col0;
#pragma unroll
                for (int bj = 0; bj < 2; ++bj) {
                    const f32x4 v0 = acc[ai][bj][m][0], v1 = acc[ai][bj][m][1];
                    u32x4 w; w.x = pk2(v0[0], v0[1]); w.y = pk2(v0[2], v0[3]); w.z = pk2(v1[0], v1[1]); w.w = pk2(v1[2], v1[3]);
                    *(u32x4*)(rowp + bj * 128) = w;
                }
            }
    }
};
struct EpiF32 {
    static constexpr bool PERM = false, AFTER_DRAIN = false;
    float* O; int ldc;
    __device__ __forceinline__ void operator()(const f32x4 (&acc)[2][2][4][2], const pg8::Unit& u, int wr, int wc, int fr, int fq) const {
        __builtin_amdgcn_sched_barrier(0); asm volatile("s_nop 7\n\ts_nop 7\n\ts_nop 7" ::: "memory"); __builtin_amdgcn_sched_barrier(0);
        const int row0 = u.pm * 256 + wr * 64 + fr;
        const int col0 = u.pn * 256 + wc * 32 + 4 * fq;
#pragma unroll
        for (int ai = 0; ai < 2; ++ai)
#pragma unroll
            for (int m = 0; m < 4; ++m) {
                float* rowp = O + (size_t)(row0 + ai * 128 + m * 16) * ldc + col0;
#pragma unroll
                for (int bj = 0; bj < 2; ++bj)
#pragma unroll
                    for (int n = 0; n < 2; ++n) *(f32x4*)(rowp + bj * 128 + n * 16) = acc[ai][bj][m][n];
            }
    }
};
struct EpiSwiGLU {
    static constexpr bool PERM = true, AFTER_DRAIN = false;
    bf16_t* O;
    __device__ __forceinline__ void operator()(const f32x4 (&acc)[2][2][4][2], const pg8::Unit& u, int wr, int wc, int fr, int fq) const {
        __builtin_amdgcn_sched_barrier(0); asm volatile("s_nop 7\n\ts_nop 7\n\ts_nop 7" ::: "memory"); __builtin_amdgcn_sched_barrier(0);
        const int row0 = u.pm * 256 + wr * 64 + fr;
        const int col0 = u.pn * 128 + wc * 32 + 8 * fq;
#pragma unroll
        for (int ai = 0; ai < 2; ++ai)
#pragma unroll
            for (int m = 0; m < 4; ++m) {
                bf16_t* rowp = O + (size_t)(row0 + ai * 128 + m * 16) * FF + col0;
                const f32x4 g0 = acc[ai][0][m][0], g1 = acc[ai][0][m][1], u0 = acc[ai][1][m][0], u1 = acc[ai][1][m][1];
                u32x4 w;
                w.x = pk2(siluf(g0[0]) * u0[0], siluf(g0[1]) * u0[1]); w.y = pk2(siluf(g0[2]) * u0[2], siluf(g0[3]) * u0[3]);
                w.z = pk2(siluf(g1[0]) * u1[0], siluf(g1[1]) * u1[1]); w.w = pk2(siluf(g1[2]) * u1[2], siluf(g1[3]) * u1[3]);
                *(u32x4*)(rowp) = w;
            }
    }
};

template <int MODE>
__device__ __forceinline__ void transpose_item(const float* W, int K, int ldw, int nblk, bf16_t* WT, LAS float* scr, int item, int lane) {
    const int kb = item / nblk, nb = item % nblk, k0 = 64 * kb, n0 = 32 * nb;
    f32x4 tv[8];
#pragma unroll
    for (int i = 0; i < 8; ++i) tv[i] = *(const f32x4*)(W + (size_t)(k0 + (lane >> 3) + 8 * i) * ldw + n0 + (lane & 7) * 4);
#pragma unroll
    for (int i = 0; i < 8; ++i) { LAS float* d = scr + ((lane >> 3) + 8 * i) * 33 + (lane & 7) * 4; d[0] = tv[i][0]; d[1] = tv[i][1]; d[2] = tv[i][2]; d[3] = tv[i][3]; }
    LDS_WAIT(); asm volatile("" ::: "memory");
    const int c = lane & 7;
#pragma unroll
    for (int j = 0; j < 4; ++j) {
        const int n = (lane >> 3) + 8 * j; const LAS float* s = scr + (8 * c) * 33 + n;
        u32x4 o; o.x = pk2(s[0 * 33], s[1 * 33]); o.y = pk2(s[2 * 33], s[3 * 33]); o.z = pk2(s[4 * 33], s[5 * 33]); o.w = pk2(s[6 * 33], s[7 * 33]);
        int dn = n0 + n;
        if (MODE == 1) { if (dn < FF) dn = (dn >> 7) * 256 + (dn & 127); else { const int d2 = dn - FF; dn = (d2 >> 7) * 256 + 128 + (d2 & 127); } }
        *(u32x4*)(WT + (size_t)dn * K + k0 + 8 * c) = o;
    }
    LDS_WAIT(); asm volatile("" ::: "memory");
}

struct TItem { const float* W; bf16_t* WT; int K, ldw, nblk, mode, idx; };
__device__ __forceinline__ void titem_load(const TItem& t, int lane, f32x4 (&tv)[8]) {
    const int kb = t.idx / t.nblk, nb = t.idx % t.nblk, k0 = 64 * kb, n0 = 32 * nb;
#pragma unroll
    for (int i = 0; i < 8; ++i) tv[i] = __builtin_nontemporal_load((const f32x4*)(t.W + (size_t)(k0 + (lane >> 3) + 8 * i) * t.ldw + n0 + (lane & 7) * 4));
}
__device__ __forceinline__ void titem_store(const TItem& t, int lane, const f32x4 (&tv)[8], LAS float* scr) {
    const int kb = t.idx / t.nblk, nb = t.idx % t.nblk, k0 = 64 * kb, n0 = 32 * nb;
#pragma unroll
    for (int i = 0; i < 8; ++i) { LAS float* d = scr + ((lane >> 3) + 8 * i) * 33 + (lane & 7) * 4; d[0] = tv[i][0]; d[1] = tv[i][1]; d[2] = tv[i][2]; d[3] = tv[i][3]; }
    LDS_WAIT(); asm volatile("" ::: "memory");
    const int c = lane & 7;
#pragma unroll
    for (int j = 0; j < 4; ++j) {
        const int n = (lane >> 3) + 8 * j; const LAS float* s = scr + (8 * c) * 33 + n;
        u32x4 o; o.x = pk2(s[0 * 33], s[1 * 33]); o.y = pk2(s[2 * 33], s[3 * 33]); o.z = pk2(s[4 * 33], s[5 * 33]); o.w = pk2(s[6 * 33], s[7 * 33]);
        int dn = n0 + n;
        if (t.mode == 1) { if (dn < FF) dn = (dn >> 7) * 256 + (dn & 127); else { const int d2 = dn - FF; dn = (d2 >> 7) * 256 + 128 + (d2 & 127); } }
        *(u32x4*)(t.WT + (size_t)dn * t.K + k0 + 8 * c) = o;
    }
    LDS_WAIT(); asm volatile("" ::: "memory");
}

struct Args { const float* in[13]; float* out; unsigned char* ws; int ph_lo, ph_hi; };

__device__ __forceinline__ int t5_bucket(int n) {
    if (n < 16) return n;
    const float v = logf((float)n / 16.0f) / 2.0794415416798357f * 16.0f;
    int l = 16 + (int)v; return l < 31 ? l : 31;
}

__device__ __forceinline__ void phase_prologue(LAS unsigned char* lds, const Args& a) {
    const int tid = threadIdx.x, lane = tid & 63, wave = tid >> 6;
    const int gw = blockIdx.x * 8 + wave, NGW = gridDim.x * 8;
    unsigned char* ws = a.ws;
    LAS float* scr = (LAS float*)(lds + wave * 16384);
    constexpr int I_IN = (DM / 64) * (NPROJ / 32), I_SQ = (DM / 64) * (DM / 32), I_GU = (DM / 64) * (2 * FF / 32), I_DN = (FF / 64) * (DM / 32), I_SWA = (DM / 64) * (NQKV / 32);
    constexpr int NITEMS = I_IN + 2 * I_SQ + 2 * I_GU + 2 * I_DN + I_SWA;
    auto decode = [&](int it) -> TItem {
        int r = it; TItem t;
        if (r < I_IN) { t = TItem{a.in[5], (bf16_t*)(ws + OFF_WIN), DM, RMCOLS, NPROJ / 32, 0, r}; return t; } r -= I_IN;
        if (r < I_SQ) { t = TItem{a.in[9], (bf16_t*)(ws + OFF_WOUT0), DM, DM, DM / 32, 0, r}; return t; } r -= I_SQ;
        if (r < I_GU) { t = TItem{a.in[3], (bf16_t*)(ws + OFF_WGU0), DM, 2 * FF, 2 * FF / 32, 1, r}; return t; } r -= I_GU;
        if (r < I_DN) { t = TItem{a.in[4], (bf16_t*)(ws + OFF_WD0), FF, DM, DM / 32, 0, r}; return t; } r -= I_DN;
        if (r < I_SWA) { t = TItem{a.in[10], (bf16_t*)(ws + OFF_WSWA), DM, NQKV, NQKV / 32, 0, r}; return t; } r -= I_SWA;
        if (r < I_SQ) { t = TItem{a.in[12], (bf16_t*)(ws + OFF_WO1), DM, DM, DM / 32, 0, r}; return t; } r -= I_SQ;
        if (r < I_GU) { t = TItem{a.in[3] + (size_t)DM * 2 * FF, (bf16_t*)(ws + OFF_WGU1), DM, 2 * FF, 2 * FF / 32, 1, r}; return t; } r -= I_GU;
        t = TItem{a.in[4] + (size_t)FF * DM, (bf16_t*)(ws + OFF_WD1), FF, DM, DM / 32, 0, r}; return t;
    };
    if (gw < NITEMS) {
        TItem cur = decode(gw); f32x4 tv[8]; titem_load(cur, lane, tv);
        for (int it = gw; it < NITEMS; it += NGW) {
            const int nx = it + NGW < NITEMS ? it + NGW : it;
            const TItem nxt = decode(nx); f32x4 tn[8]; titem_load(nxt, lane, tn);
            titem_store(cur, lane, tv, scr);
            cur = nxt;
#pragma unroll
            for (int i = 0; i < 8; ++i) tv[i] = tn[i];
        }
    }
    {
        float* cosT = (float*)(ws + OFF_COS); float* sinT = (float*)(ws + OFF_SIN);
        for (int idx = blockIdx.x * 512 + tid; idx < SEQ_T * 128; idx += gridDim.x * 512) {
            const int pos = idx >> 7, i = idx & 127;
            const float t = (float)i / 127.0f;
            const float inv = 1.0f / exp2f(13.287712379549449f * t);
            const float ang = (float)pos * inv;
            const double ad = (double)ang;
            const double nrev = rint(ad * 0.15915494309189535);
            const float rf = (float)(ad - nrev * 6.283185307179586);
            cosT[idx] = __cosf(rf); sinT[idx] = __sinf(rf);
        }
        float* biasT = (float*)(ws + OFF_BIAS);
        for (int idx = blockIdx.x * 512 + tid; idx < 32 * 128; idx += gridDim.x * 512) {
            const int h = idx >> 7, dist = idx & 127;
            biasT[idx] = a.in[1][t5_bucket(dist) * 32 + h];
        }
    }
    __syncthreads();
    LAS float* WgS = (LAS float*)lds;
    for (int idx = tid; idx < 8 * DM; idx += 512) { const int k = idx >> 3, c = idx & 7; WgS[c * DM + k] = a.in[5][(size_t)k * RMCOLS + NPROJ + c]; }
    __syncthreads();
    const float* x = a.in[0]; const float* g0 = a.in[2];
    bf16_t* hn = (bf16_t*)(ws + OFF_H); float* gates = (float*)(ws + OFF_GATES);
    f32x4 gv[8];
#pragma unroll
    for (int j = 0; j < 8; ++j) gv[j] = ((const f32x4*)g0)[lane + 64 * j];
    float gbias[8];
#pragma unroll
    for (int c = 0; c < 8; ++c) gbias[c] = a.in[7][c];
    f32x4 v[8];
    if (gw < M_TOK) {
#pragma unroll
        for (int j = 0; j < 8; ++j) v[j] = __builtin_nontemporal_load((const f32x4*)(x + (size_t)gw * DM) + lane + 64 * j);
    }
    for (int m = gw; m < M_TOK; m += NGW) {
        const int mn = m + NGW < M_TOK ? m + NGW : m;
        f32x4 vn[8];
#pragma unroll
        for (int j = 0; j < 8; ++j) vn[j] = __builtin_nontemporal_load((const f32x4*)(x + (size_t)mn * DM) + lane + 64 * j);
        float ss = 0.f;
#pragma unroll
        for (int j = 0; j < 8; ++j) ss += (v[j][0] * v[j][0] + v[j][1] * v[j][1]) + (v[j][2] * v[j][2] + v[j][3] * v[j][3]);
        const float rs = rsqrtf(wave_sum(ss) * (1.0f / DM) + EPS);
        u32x2* o8 = (u32x2*)(hn + (size_t)m * DM) + lane;
#pragma unroll
        for (int j = 0; j < 8; ++j) { v[j] = v[j] * rs * gv[j]; u32x2 o; o.x = pk2(v[j][0], v[j][1]); o.y = pk2(v[j][2], v[j][3]); o8[64 * j] = o; }
        float gsum[8];
#pragma unroll
        for (int c = 0; c < 8; ++c) {
            float s_ = 0.f;
#pragma unroll
            for (int j = 0; j < 8; ++j) { const f32x4 w4 = *(const LAS f32x4*)(WgS + c * DM + 4 * lane + 256 * j); s_ += (v[j][0] * w4[0] + v[j][1] * w4[1]) + (v[j][2] * w4[2] + v[j][3] * w4[3]); }
            gsum[c] = wave_sum(s_);
        }
        if (lane == 0) {
#pragma unroll
            for (int c = 0; c < 8; ++c) gates[(size_t)m * 8 + c] = gsum[c] + gbias[c];
        }
#pragma unroll
        for (int j = 0; j < 8; ++j) v[j] = vn[j];
    }
    __syncthreads();
}

template <bool XIN_BF16>
__device__ __forceinline__ void normres_load(const void* xin_, const bf16_t* y, int m, int lane, u32x2 (&yv)[8], f32x4 (&xv)[8]) {
    const u32x2* yr = (const u32x2*)(y + (size_t)m * DM) + lane;
#pragma unroll
    for (int j = 0; j < 8; ++j) {
        yv[j] = __builtin_nontemporal_load(yr + 64 * j);
        if (XIN_BF16) { const u32x2 xx = __builtin_nontemporal_load((const u32x2*)((const bf16_t*)xin_ + (size_t)m * DM) + lane + 64 * j); xv[j] = (f32x4){bflo(xx.x), bfhi(xx.x), bflo(xx.y), bfhi(xx.y)}; }
        else xv[j] = __builtin_nontemporal_load((const f32x4*)((const float*)xin_ + (size_t)m * DM) + lane + 64 * j);
    }
}
template <bool XIN_BF16, bool XOUT_BF16>
__device__ __forceinline__ void phase_normres(const void* xin_, void* xout_, const bf16_t* y, const float* gA, const float* gB, bf16_t* hn) {
    const int tid = threadIdx.x, lane = tid & 63, wave = tid >> 6;
    const int gw = blockIdx.x * 8 + wave, NGW = gridDim.x * 8;
    if (gw >= M_TOK) return;
    f32x4 gav[8], gbv[8];
#pragma unroll
    for (int j = 0; j < 8; ++j) { gav[j] = ((const f32x4*)gA)[lane + 64 * j]; gbv[j] = gB ? ((const f32x4*)gB)[lane + 64 * j] : (f32x4){0.f, 0.f, 0.f, 0.f}; }
    u32x2 yv[8]; f32x4 xv[8];
    normres_load<XIN_BF16>(xin_, y, gw, lane, yv, xv);
    for (int m = gw; m < M_TOK; m += NGW) {
        u32x2 yn[8]; f32x4 xn[8];
        const bool more = m + NGW < M_TOK;
        normres_load<XIN_BF16>(xin_, y, more ? m + NGW : m, lane, yn, xn);
        f32x4 v[8]; float ss = 0.f;
#pragma unroll
        for (int j = 0; j < 8; ++j) { v[j] = (f32x4){bflo(yv[j].x), bfhi(yv[j].x), bflo(yv[j].y), bfhi(yv[j].y)}; ss += (v[j][0] * v[j][0] + v[j][1] * v[j][1]) + (v[j][2] * v[j][2] + v[j][3] * v[j][3]); }
        const float rs = rsqrtf(wave_sum(ss) * (1.0f / DM) + EPS);
        float s2 = 0.f;
#pragma unroll
        for (int j = 0; j < 8; ++j) {
            const f32x4 ga = gav[j];
            xv[j] = xv[j] + v[j] * rs * ga;
            if (XOUT_BF16) { u32x2 o; o.x = pk2(xv[j][0], xv[j][1]); o.y = pk2(xv[j][2], xv[j][3]); __builtin_nontemporal_store(o, (u32x2*)((bf16_t*)xout_ + (size_t)m * DM) + lane + 64 * j); }
            else __builtin_nontemporal_store(xv[j], (f32x4*)((float*)xout_ + (size_t)m * DM) + lane + 64 * j);
            s2 += (xv[j][0] * xv[j][0] + xv[j][1] * xv[j][1]) + (xv[j][2] * xv[j][2] + xv[j][3] * xv[j][3]);
        }
        if (gB) {
            const float r2 = rsqrtf(wave_sum(s2) * (1.0f / DM) + EPS);
            u32x2* o8 = (u32x2*)(hn + (size_t)m * DM) + lane;
#pragma unroll
            for (int j = 0; j < 8; ++j) {
                const f32x4 gb = gbv[j];
                const f32x4 h = xv[j] * r2 * gb; u32x2 o; o.x = pk2(h[0], h[1]); o.y = pk2(h[2], h[3]); o8[64 * j] = o;
            }
        }
        if (!more) break;
#pragma unroll
        for (int j = 0; j < 8; ++j) { yv[j] = yn[j]; xv[j] = xn[j]; }
    }
}

__device__ __forceinline__ void combine_load(const bf16_t* mixI, const bf16_t* mixE, const float* denI, const float* denE, const float* flrA, const bf16_t* proj, int m, int lane,
                                             u32x2 (&vi)[8], u32x2 (&ve)[8], u32x2 (&gg)[8], float (&dn)[4], float (&fl)[4]) {
    const u32x2* ir = (const u32x2*)(mixI + (size_t)m * DM) + lane;
    const u32x2* er = (const u32x2*)(mixE + (size_t)m * DM) + lane;
    const bf16_t* pr = proj + (size_t)m * NPROJ;
#pragma unroll
    for (int j = 0; j < 8; ++j) { vi[j] = __builtin_nontemporal_load(ir + 64 * j); ve[j] = __builtin_nontemporal_load(er + 64 * j); gg[j] = *(const u32x2*)(pr + (j < 4 ? 3072 + 256 * j : 7168 + 256 * (j - 4)) + 4 * lane); }
    const int bb = m >> 12, pos = m & (SEQ_T - 1);
#pragma unroll
    for (int hh = 0; hh < 4; ++hh) { const int gi = (bb * 4 + hh) * SEQ_T + pos; dn[hh] = denI[gi] + denE[gi]; fl[hh] = flrA[gi]; }
}
__device__ __forceinline__ void phase_combine(const bf16_t* mixI, const bf16_t* mixE, const float* denI, const float* denE, const float* flrA, const bf16_t* proj, const float* head_g, bf16_t* cat) {
    const int tid = threadIdx.x, lane = tid & 63, wave = tid >> 6;
    const int gw = blockIdx.x * 8 + wave, NGW = gridDim.x * 8;
    if (gw >= M_TOK) return;
    f32x4 hgv[8];
#pragma unroll
    for (int j = 0; j < 8; ++j) hgv[j] = ((const f32x4*)head_g)[lane + 64 * j];
    u32x2 vi[8], ve[8], gg[8]; float dn[4], fl[4];
    combine_load(mixI, mixE, denI, denE, flrA, proj, gw, lane, vi, ve, gg, dn, fl);
    for (int m = gw; m < M_TOK; m += NGW) {
        u32x2 vin[8], ven[8], ggn[8]; float dnn[4], fln[4];
        combine_load(mixI, mixE, denI, denE, flrA, proj, m + NGW < M_TOK ? m + NGW : m, lane, vin, ven, ggn, dnn, fln);
        u32x2* o8 = (u32x2*)(cat + (size_t)m * DM) + lane;
#pragma unroll
        for (int j = 0; j < 8; ++j) {
            f32x4 v = (f32x4){bflo(vi[j].x) + bflo(ve[j].x), bfhi(vi[j].x) + bfhi(ve[j].x), bflo(vi[j].y) + bflo(ve[j].y), bfhi(vi[j].y) + bfhi(ve[j].y)};
            if (j >= 4) v = v * (1.0f / fmaxf(fabsf(dn[j - 4]), fl[j - 4]));
            const float ss = wave_sum((v[0] * v[0] + v[1] * v[1]) + (v[2] * v[2] + v[3] * v[3]));
            const float rs = rsqrtf(ss * (1.0f / 256.0f) + EPS);
            float g0 = bflo(gg[j].x), g1 = bfhi(gg[j].x), g2 = bflo(gg[j].y), g3 = bfhi(gg[j].y);
            if (j < 4) { g0 = siluf(g0); g1 = siluf(g1); g2 = siluf(g2); g3 = siluf(g3); }
            else { g0 = sigmf(g0); g1 = sigmf(g1); g2 = sigmf(g2); g3 = sigmf(g3); }
            u32x2 o; o.x = pk2(v[0] * rs * hgv[j][0] * g0, v[1] * rs * hgv[j][1] * g1); o.y = pk2(v[2] * rs * hgv[j][2] * g2, v[3] * rs * hgv[j][3] * g3);
            o8[64 * j] = o;
        }
#pragma unroll
        for (int j = 0; j < 8; ++j) { vi[j] = vin[j]; ve[j] = ven[j]; gg[j] = ggn[j]; }
#pragma unroll
        for (int hh = 0; hh < 4; ++hh) { dn[hh] = dnn[hh]; fl[hh] = fln[hh]; }
    }
}

constexpr int MX_P = 136;
constexpr int MX_RP = 264;
constexpr int MX_QS = 0, MX_KS = 34816, MX_RT = 69632, MX_V0 = MX_RT + 48 * MX_RP * 2, MX_V1 = MX_V0 + 48 * MX_P * 2, MX_ARR = MX_V1 + 48 * MX_P * 2;
static_assert(MX_ARR + 6 * 512 <= LDS_BYTES, "mixer LDS");

__device__ __forceinline__ void unpack8(const u32x4 v, f32x4& lo, f32x4& hi) { lo = (f32x4){bflo(v.x), bfhi(v.x), bflo(v.y), bfhi(v.y)}; hi = (f32x4){bflo(v.z), bfhi(v.z), bflo(v.w), bfhi(v.w)}; }
template <int CTRL, int ROWMASK> __device__ __forceinline__ float dpp_id(float identity, float v) { return __int_as_float(__builtin_amdgcn_update_dpp(__float_as_int(identity), __float_as_int(v), CTRL, ROWMASK, 0xf, false)); }
__device__ __forceinline__ float wave_scan_sum(float v) {
    v += dpp_id<0x111, 0xf>(0.f, v); v += dpp_id<0x112, 0xf>(0.f, v); v += dpp_id<0x114, 0xf>(0.f, v); v += dpp_id<0x118, 0xf>(0.f, v);
    v += dpp_id<0x142, 0xa>(0.f, v); v += dpp_id<0x143, 0xc>(0.f, v); return v;
}
__device__ __forceinline__ float wave_scan_max(float v) {
    v = fmaxf(v, dpp_id<0x111, 0xf>(-INFINITY, v)); v = fmaxf(v, dpp_id<0x112, 0xf>(-INFINITY, v)); v = fmaxf(v, dpp_id<0x114, 0xf>(-INFINITY, v)); v = fmaxf(v, dpp_id<0x118, 0xf>(-INFINITY, v));
    v = fmaxf(v, dpp_id<0x142, 0xa>(-INFINITY, v)); v = fmaxf(v, dpp_id<0x143, 0xc>(-INFINITY, v)); return v;
}
struct GateArrays { float* rowl; float* coll; float* wq; float* wcol; float* flr; float* dec; };
__device__ __forceinline__ float logsigf(float f) { return fminf(f, 0.f) - log1pf(__expf(-fabsf(f))); }
__device__ __forceinline__ void gate_prepass(const float* gates, const GateArrays& G, int unit, int lane) {
    const int b = unit >> 2, h = unit & 3;
    float m_prev = 0.f;
#pragma unroll 1
    for (int c8 = 0; c8 < 32; c8 += 8) {
        float gi0[8], gf0[8], gi1[8], gf1[8];
#pragma unroll
        for (int u = 0; u < 8; ++u) {
            const float* gp = gates + (size_t)(b * SEQ_T + (c8 + u) * 128 + 2 * lane) * 8;
            gi0[u] = gp[h]; gf0[u] = gp[4 + h]; gi1[u] = gp[8 + h]; gf1[u] = gp[12 + h];
        }
#pragma unroll
        for (int u = 0; u < 8; ++u) {
            const int c = c8 + u;
            const float i0 = gi0[u], f0 = gf0[u], i1 = gi1[u], f1 = gf1[u];
            const float l0 = logsigf(f0), l1 = logsigf(f1);
            const float s = l0 + l1; const float inc = wave_scan_sum(s);
            const float exc = inc - s, b0 = exc + l0, b1 = exc + s;
            const float a0 = i0 - b0, a1 = i1 - b1;
            const float incm = wave_scan_max(fmaxf(a0, a1));
            const float Amax = __int_as_float(__builtin_amdgcn_readlane(__float_as_int(incm), 63)), bL = __int_as_float(__builtin_amdgcn_readlane(__float_as_int(b1), 63));
            float excm = __shfl_up(incm, 1); if (lane == 0) excm = -INFINITY;
            const float M0 = fmaxf(fmaxf(m_prev, excm), a0), M1 = fmaxf(M0, a1);
            const float Mlast = fmaxf(m_prev, Amax);
            const int gi = (b * 4 + h) * SEQ_T + c * 128 + 2 * lane;
            G.rowl[gi] = -M0 * LOG2E; G.rowl[gi + 1] = -M1 * LOG2E;
            G.coll[gi] = a0 * LOG2E; G.coll[gi + 1] = a1 * LOG2E;
            G.wq[gi] = __expf(m_prev - M0); G.wq[gi + 1] = __expf(m_prev - M1);
            G.wcol[gi] = __expf(a0 - Mlast); G.wcol[gi + 1] = __expf(a1 - Mlast);
            G.flr[gi] = __expf(-(b0 + M0)); G.flr[gi + 1] = __expf(-(b1 + M1));
            if (lane == 0) G.dec[(b * 4 + h) * 32 + c] = __expf(m_prev - Mlast);
            m_prev = bL + Mlast;
        }
    }
}

__device__ __forceinline__ void phase_conv(const bf16_t* proj, const float* convw, bf16_t* cq, const float* gates, const GateArrays& G) {
    if ((threadIdx.x >> 6) == 0) { for (int unit = blockIdx.x; unit < 16; unit += gridDim.x) gate_prepass(gates, G, unit, threadIdx.x & 63); }
    const int gt = blockIdx.x * 512 + threadIdx.x, NT = gridDim.x * 512;
    for (int u = gt; u < 1024 * 256; u += NT) {
        const int ch = (u & 255) * 8, strip = u >> 8, row0 = strip * 16;
        f32x4 w0[4], w1[4];
#pragma unroll
        for (int kk = 0; kk < 4; ++kk) { w0[kk] = *(const f32x4*)(convw + kk * 2048 + ch); w1[kk] = *(const f32x4*)(convw + kk * 2048 + ch + 4); }
        const float scale = ch >= 1024 ? 0.0625f : 1.0f;
        const bf16_t* src = proj + (size_t)row0 * NPROJ + 4096 + ch;
        bf16_t* dst = cq + (size_t)row0 * DM + ch;
        f32x4 a3l = {0.f, 0.f, 0.f, 0.f}, a3h = a3l, a2l = a3l, a2h = a3l, a1l = a3l, a1h = a3l;
        if ((row0 & (SEQ_T - 1)) != 0) {
            unpack8(*(const u32x4*)(src - 3 * NPROJ), a3l, a3h); unpack8(*(const u32x4*)(src - 2 * NPROJ), a2l, a2h); unpack8(*(const u32x4*)(src - 1 * NPROJ), a1l, a1h);
        }
#pragma unroll 1
        for (int r8 = 0; r8 < 16; r8 += 8) {
            u32x4 raw[8];
#pragma unroll
            for (int r = 0; r < 8; ++r) raw[r] = *(const u32x4*)(src + (size_t)(r8 + r) * NPROJ);
#pragma unroll
            for (int r = 0; r < 8; ++r) {
                f32x4 cl, chh; unpack8(raw[r], cl, chh);
                const f32x4 sl_ = w0[0] * a3l + w0[1] * a2l + w0[2] * a1l + w0[3] * cl;
                const f32x4 sh_ = w1[0] * a3h + w1[1] * a2h + w1[2] * a1h + w1[3] * chh;
                u32x4 o;
                o.x = pk2(siluf(sl_[0]) * scale, siluf(sl_[1]) * scale); o.y = pk2(siluf(sl_[2]) * scale, siluf(sl_[3]) * scale);
                o.z = pk2(siluf(sh_[0]) * scale, siluf(sh_[1]) * scale); o.w = pk2(siluf(sh_[2]) * scale, siluf(sh_[3]) * scale);
                *(u32x4*)(dst + (size_t)(r8 + r) * DM) = o;
                a3l = a2l; a3h = a2h; a2l = a1l; a2h = a1h; a1l = cl; a1h = chh;
            }
        }
    }
}

template <int NE>
__device__ __forceinline__ void state_update(f32x4 (&St)[NE], float decay, const LAS bf16_t* KS, const LAS bf16_t* V1, int w, int fr, int fq) {
#pragma unroll
    for (int e = 0; e < NE; ++e) St[e] = St[e] * decay;
#pragma unroll
    for (int ks = 0; ks < 4; ++ks) {
        bf16x8 bg;
#pragma unroll
        for (int i = 0; i < 8; ++i) bg[i] = (short)KS[(ks * 32 + fq * 8 + i) * 136 + 16 * w + fr];
#pragma unroll
        for (int e = 0; e < NE; ++e) { const bf16x8 af = *(const LAS bf16x8*)(V1 + (16 * e + fr) * 136 + ks * 32 + fq * 8); St[e] = MFMA16(af, bg, St[e]); }
    }
}

template <int NE>
__device__ __forceinline__ void inter_piece(f32x4 (&Oi)[NE], f32x4 (&St)[NE], float decay, const LAS bf16_t* QS, const LAS bf16_t* KS, const LAS bf16_t* RTp, const LAS bf16_t* V1, int w, int fr, int fq) {
#pragma unroll
    for (int kk = 0; kk < 4; ++kk) {
        const bf16x8 af = *(const LAS bf16x8*)(QS + (16 * w + fr) * 136 + kk * 32 + fq * 8);
#pragma unroll
        for (int e = 0; e < NE; ++e) { const bf16x8 br = *(const LAS bf16x8*)(RTp + (16 * e + fr) * 264 + kk * 32 + fq * 8); Oi[e] = MFMA16(af, br, Oi[e]); }
    }
    state_update<NE>(St, decay, KS, V1, w, fr, fq);
}

constexpr int IT_RT = 0, IT_V1 = 2 * 48 * MX_RP * 2, IT_KP = IT_V1 + 2 * 48 * MX_P * 2, IT_END = IT_KP + 8 * 4096;
static_assert(IT_END <= LDS_BYTES - 64, "inter LDS");
template <int TYPE>
__device__ __forceinline__ void inter_item(LAS unsigned char* lds, const bf16_t* proj, const bf16_t* cq, const float* gaWQ, const float* gaWCOL, const float* gaDEC,
                                           bf16_t* mixE, float* denE, int b, int h, int sl) {
    constexpr int NE = TYPE ? 3 : 2;
    const int tid0 = threadIdx.x, w = __builtin_amdgcn_readfirstlane(tid0 >> 6);
    int tid = tid0;
    LAS bf16_t* RTb = (LAS bf16_t*)(lds + IT_RT); LAS bf16_t* V1b = (LAS bf16_t*)(lds + IT_V1);
    LAS bf16_t* KP = (LAS bf16_t*)(lds + IT_KP + w * 4096);
    const bf16_t* qsrc = TYPE ? cq + h * 256 : proj + h * 256;
    const bf16_t* ksrc = TYPE ? cq + 1024 + h * 256 : proj + 1024 + h * 256;
    const int qpitch = TYPE ? DM : NPROJ;
    const bf16_t* vsrc = proj + (TYPE ? 6144 + h * 256 : 2048 + h * 256) + sl * 32;
    const int g0 = (b * 4 + h) * SEQ_T;
    const float lg2 = log2f(1.0f - exp2f(-5.0f - (float)h));
    for (int i = tid; i < 2 * 48 * MX_RP / 2; i += 512) ((LAS unsigned*)RTb)[i] = 0u;
    for (int i = tid; i < 2 * 48 * MX_P / 2; i += 512) ((LAS unsigned*)V1b)[i] = 0u;
    f32x4 St[2][NE];
#pragma unroll
    for (int p = 0; p < 2; ++p)
#pragma unroll
        for (int e = 0; e < NE; ++e) St[p][e] = (f32x4){0.f, 0.f, 0.f, 0.f};
    bf16x8 qn[8]; u32x4 kb[2][4], pv; float pwc = 0.f, decay_n = 0.f; f32x4 wq_n = {0.f, 0.f, 0.f, 0.f};
    {
        const int lane = tid & 63, fr = lane & 15, fq = lane >> 4, t0 = b * SEQ_T;
        pv = *(const u32x4*)(vsrc + (size_t)(t0 + (tid >> 2)) * NPROJ + (tid & 3) * 8);
        if (TYPE == 1) { pwc = gaWCOL[g0 + (tid >> 2)]; decay_n = gaDEC[(b * 4 + h) * 32]; wq_n = *(const f32x4*)(gaWQ + g0 + 16 * w + fq * 4); }
#pragma unroll
        for (int kk = 0; kk < 8; ++kk) qn[kk] = *(const bf16x8*)(qsrc + (size_t)(t0 + 16 * w + fr) * qpitch + kk * 32 + fq * 8);
#pragma unroll
        for (int p = 0; p < 2; ++p)
#pragma unroll
            for (int k = 0; k < 4; ++k) kb[p][k] = *(const u32x4*)(ksrc + (size_t)(t0 + (lane >> 1) + 32 * k) * qpitch + p * 128 + 16 * w + (lane & 1) * 8);
    }
    __syncthreads();
    for (int c = 0; c < 32; ++c) {
        asm volatile("" : "+v"(tid));
        const int lane = tid & 63, fr = lane & 15, fq = lane >> 4;
        const int cn = c + 1 < 32 ? c + 1 : c;
        const int t0 = b * SEQ_T + c * 128, tn = b * SEQ_T + cn * 128;
        LAS bf16_t* RT = RTb + (c & 1) * 48 * MX_RP; LAS bf16_t* RTn = RTb + ((c & 1) ^ 1) * 48 * MX_RP;
        LAS bf16_t* V1 = V1b + (c & 1) * 48 * MX_P;
        float decay; f32x4 wq4;
        if (TYPE == 1) {
            decay = decay_n; wq4 = wq_n;
            decay_n = gaDEC[(b * 4 + h) * 32 + cn]; wq_n = *(const f32x4*)(gaWQ + g0 + cn * 128 + 16 * w + fq * 4);
        } else { decay = exp2f(128.0f * lg2); const float i0 = (float)(16 * w + fq * 4 + 1); wq4 = (f32x4){exp2f(i0 * lg2), exp2f((i0 + 1.f) * lg2), exp2f((i0 + 2.f) * lg2), exp2f((i0 + 3.f) * lg2)}; }
        {
            const int j = tid >> 2, part = tid & 3;
            const float wc_ = TYPE ? pwc : exp2f((float)(127 - j) * lg2);
            const unsigned uu[4] = {pv.x, pv.y, pv.z, pv.w};
#pragma unroll
            for (int q = 0; q < 4; ++q) {
                V1[(part * 8 + 2 * q) * MX_P + j] = (bf16_t)f2bf(bflo(uu[q]) * wc_); V1[(part * 8 + 2 * q + 1) * MX_P + j] = (bf16_t)f2bf(bfhi(uu[q]) * wc_);
            }
            if (TYPE == 1 && part == 0) V1[32 * MX_P + j] = (bf16_t)f2bf(wc_);
            pv = *(const u32x4*)(vsrc + (size_t)(tn + (tid >> 2)) * NPROJ + (tid & 3) * 8); if (TYPE == 1) pwc = gaWCOL[g0 + cn * 128 + (tid >> 2)];
        }
        bf16x8 qa[8];
#pragma unroll
        for (int kk = 0; kk < 8; ++kk) qa[kk] = qn[kk];
#pragma unroll
        for (int kk = 0; kk < 8; ++kk) qn[kk] = *(const bf16x8*)(qsrc + (size_t)(tn + 16 * w + fr) * qpitch + kk * 32 + fq * 8);
        __syncthreads();
        f32x4 Oi[NE];
#pragma unroll
        for (int e = 0; e < NE; ++e) Oi[e] = (f32x4){0.f, 0.f, 0.f, 0.f};
#pragma unroll
        for (int kk = 0; kk < 8; ++kk) {
#pragma unroll
            for (int e = 0; e < NE; ++e) { const bf16x8 br = *(const LAS bf16x8*)(RT + (16 * e + fr) * MX_RP + kk * 32 + fq * 8); Oi[e] = MFMA16(qa[kk], br, Oi[e]); }
        }
#pragma unroll
        for (int p = 0; p < 2; ++p) {
#pragma unroll
            for (int k = 0; k < 4; ++k) *(LAS u32x4*)(KP + ((lane >> 1) + 32 * k) * 16 + (lane & 1) * 8) = kb[p][k];
#pragma unroll
            for (int k = 0; k < 4; ++k) kb[p][k] = *(const u32x4*)(ksrc + (size_t)(tn + (lane >> 1) + 32 * k) * qpitch + p * 128 + 16 * w + (lane & 1) * 8);
            LDS_WAIT(); asm volatile("" ::: "memory");
#pragma unroll
            for (int e = 0; e < NE; ++e) St[p][e] = St[p][e] * decay;
#pragma unroll
            for (int ks = 0; ks < 4; ++ks) {
                bf16x8 bg;
#pragma unroll
                for (int i = 0; i < 8; ++i) bg[i] = (short)KP[(ks * 32 + fq * 8 + i) * 16 + fr];
#pragma unroll
                for (int e = 0; e < NE; ++e) { const bf16x8 af = *(const LAS bf16x8*)(V1 + (16 * e + fr) * MX_P + ks * 32 + fq * 8); St[p][e] = MFMA16(af, bg, St[p][e]); }
            }
            LDS_WAIT(); asm volatile("" ::: "memory");
        }
#pragma unroll
        for (int p = 0; p < 2; ++p)
#pragma unroll
            for (int e = 0; e < NE; ++e)
#pragma unroll
                for (int jj = 0; jj < 4; ++jj) RTn[(16 * e + fq * 4 + jj) * MX_RP + p * 128 + 16 * w + fr] = (bf16_t)f2bf(St[p][e][jj]);
#pragma unroll
        for (int jj = 0; jj < 4; ++jj) {
#pragma unroll
            for (int e = 0; e < 2; ++e) KP[(fq * 4 + jj) * 40 + 16 * e + fr] = (bf16_t)f2bf(Oi[e][jj] * wq4[jj]);
            if (TYPE == 1 && sl == 0 && fr == 0) denE[g0 + c * 128 + 16 * w + fq * 4 + jj] = Oi[NE - 1][jj] * wq4[jj];
        }
        LDS_WAIT(); asm volatile("" ::: "memory");
        {
            const u32x4 ov = *(const LAS u32x4*)(KP + (lane >> 2) * 40 + (lane & 3) * 8);
            *(u32x4*)(mixE + (size_t)(t0 + 16 * w + (lane >> 2)) * DM + TYPE * 1024 + h * 256 + sl * 32 + (lane & 3) * 8) = ov;
        }
        LDS_WAIT(); asm volatile("" ::: "memory");
    }
    __syncthreads();
}

constexpr int IN_VT = 69632, IN_ARR = IN_VT + 272 * MX_P * 2;
static_assert(IN_ARR + 1024 <= LDS_BYTES - 64, "intra LDS");
__device__ __forceinline__ void intra_s_piece(f32x4 (&S)[8], const LAS bf16_t* QS, const LAS bf16_t* KS, int w, int fr, int fq) {
#pragma unroll 2
    for (int kk = 0; kk < 4; ++kk) {
        const bf16x8 af = *(const LAS bf16x8*)(QS + (16 * w + fr) * 136 + kk * 32 + fq * 8);
        bf16x8 bq[4];
#pragma unroll
        for (int n = 0; n < 4; ++n) bq[n] = *(const LAS bf16x8*)(KS + (16 * n + fr) * 136 + kk * 32 + fq * 8);
#pragma unroll
        for (int n = 0; n < 4; ++n) S[n] = MFMA16(af, bq[n], S[n]);
        if (w >= 4) {
#pragma unroll
            for (int n = 0; n < 4; ++n) bq[n] = *(const LAS bf16x8*)(KS + (16 * (n + 4) + fr) * 136 + kk * 32 + fq * 8);
#pragma unroll
            for (int n = 0; n < 4; ++n) S[n + 4] = MFMA16(af, bq[n], S[n + 4]);
        }
    }
}

template <int TYPE>
__device__ __forceinline__ void intra_item(LAS unsigned char* lds, const bf16_t* proj, const bf16_t* cq, const float* gaROWL, const float* gaCOLL,
                                           bf16_t* mixI, float* denI, int b, int h, int c) {
    const int tid = threadIdx.x, lane = tid & 63, w = __builtin_amdgcn_readfirstlane(tid >> 6), fr = lane & 15, fq = lane >> 4;
    LAS bf16_t* QS = (LAS bf16_t*)(lds + MX_QS); LAS bf16_t* KS = (LAS bf16_t*)(lds + MX_KS); LAS bf16_t* VT = (LAS bf16_t*)(lds + IN_VT);
    LAS float* rowl = (LAS float*)(lds + IN_ARR); LAS float* coll = rowl + 128;
    const bf16_t* qsrc = TYPE ? cq + h * 256 : proj + h * 256;
    const bf16_t* ksrc = TYPE ? cq + 1024 + h * 256 : proj + 1024 + h * 256;
    const int qpitch = TYPE ? DM : NPROJ;
    const bf16_t* vsrc = proj + (TYPE ? 6144 + h * 256 : 2048 + h * 256);
    const int t0 = b * SEQ_T + c * 128, g0 = (b * 4 + h) * SEQ_T + c * 128;
    const int cv = tid & 15, rb = tid >> 4;
    if (tid < 128) {
        if (TYPE == 1) { rowl[tid] = gaROWL[g0 + tid]; coll[tid] = gaCOLL[g0 + tid]; }
        else { const float lg2 = log2f(1.0f - exp2f(-5.0f - (float)h)); rowl[tid] = (float)tid * lg2; coll[tid] = -(float)tid * lg2; }
    }
    {
        u32x4 vv[8]; const int j = tid >> 2, part = tid & 3;
#pragma unroll
        for (int k = 0; k < 8; ++k) vv[k] = *(const u32x4*)(vsrc + (size_t)(t0 + j) * NPROJ + 32 * k + part * 8);
        u32x4 q0[4], k0[4];
#pragma unroll
        for (int k = 0; k < 4; ++k) {
            q0[k] = *(const u32x4*)(qsrc + (size_t)(t0 + rb + 32 * k) * qpitch + cv * 8);
            k0[k] = *(const u32x4*)(ksrc + (size_t)(t0 + rb + 32 * k) * qpitch + cv * 8);
        }
#pragma unroll
        for (int k = 0; k < 8; ++k) {
            const unsigned uu[4] = {vv[k].x, vv[k].y, vv[k].z, vv[k].w};
#pragma unroll
            for (int q = 0; q < 4; ++q) { VT[(32 * k + part * 8 + 2 * q) * MX_P + j] = (bf16_t)(uu[q] & 0xffffu); VT[(32 * k + part * 8 + 2 * q + 1) * MX_P + j] = (bf16_t)(uu[q] >> 16); }
        }
#pragma unroll
        for (int k = 0; k < 4; ++k) { *(LAS u32x4*)(QS + (rb + 32 * k) * MX_P + cv * 8) = q0[k]; *(LAS u32x4*)(KS + (rb + 32 * k) * MX_P + cv * 8) = k0[k]; }
    }
    u32x4 q1[4], k1[4];
#pragma unroll
    for (int k = 0; k < 4; ++k) {
        q1[k] = *(const u32x4*)(qsrc + (size_t)(t0 + rb + 32 * k) * qpitch + 128 + cv * 8);
        k1[k] = *(const u32x4*)(ksrc + (size_t)(t0 + rb + 32 * k) * qpitch + 128 + cv * 8);
    }
    f32x4 S[8];
#pragma unroll
    for (int n = 0; n < 8; ++n) S[n] = (f32x4){0.f, 0.f, 0.f, 0.f};
    __syncthreads();
    intra_s_piece(S, QS, KS, w, fr, fq);
    __syncthreads();
#pragma unroll
    for (int k = 0; k < 4; ++k) { *(LAS u32x4*)(QS + (rb + 32 * k) * MX_P + cv * 8) = q1[k]; *(LAS u32x4*)(KS + (rb + 32 * k) * MX_P + cv * 8) = k1[k]; }
    __syncthreads();
    intra_s_piece(S, QS, KS, w, fr, fq);
    __syncthreads();
#pragma unroll
    for (int g = 0; g < 2; ++g) if (g == 0 || w >= 4) {
#pragma unroll
        for (int jj = 0; jj < 4; ++jj) {
            const int i = 16 * w + fq * 4 + jj; const float rl = rowl[i];
#pragma unroll
            for (int n4 = 0; n4 < 4; ++n4) {
                const int n = 4 * g + n4, j = 16 * n + fr;
                const float ev = S[n][jj] * __builtin_amdgcn_exp2f(rl + coll[j]);
                QS[i * MX_P + j] = (bf16_t)f2bf((j <= i) ? ev : 0.f);
            }
        }
    }
    __syncthreads();
#pragma unroll 1
    for (int half = 0; half < 2; ++half) {
        f32x4 acc[8], accd = {0.f, 0.f, 0.f, 0.f};
#pragma unroll
        for (int t = 0; t < 8; ++t) acc[t] = (f32x4){0.f, 0.f, 0.f, 0.f};
#pragma unroll
        for (int ks = 0; ks < 4; ++ks) if (ks < 2 || w >= 4) {
            const bf16x8 af = *(const LAS bf16x8*)(QS + (16 * w + fr) * MX_P + ks * 32 + fq * 8);
#pragma unroll
            for (int t = 0; t < 8; ++t) { const bf16x8 bfr = *(const LAS bf16x8*)(VT + (16 * (8 * half + t) + fr) * MX_P + ks * 32 + fq * 8); acc[t] = MFMA16(af, bfr, acc[t]); }
            if (TYPE == 1 && half == 1) { const bf16x8 bfr = *(const LAS bf16x8*)(VT + (256 + fr) * MX_P + ks * 32 + fq * 8); accd = MFMA16(af, bfr, accd); }
        }
        LAS bf16_t* OW = KS + w * 16 * MX_P;
#pragma unroll
        for (int jj = 0; jj < 4; ++jj) {
#pragma unroll
            for (int t = 0; t < 8; ++t) OW[(fq * 4 + jj) * MX_P + 16 * t + fr] = (bf16_t)f2bf(acc[t][jj]);
            if (TYPE == 1 && half == 1 && fr == 0) denI[g0 + 16 * w + fq * 4 + jj] = accd[jj];
        }
        LDS_WAIT(); asm volatile("" ::: "memory");
#pragma unroll
        for (int k = 0; k < 4; ++k) {
            const int ch = (lane & 3) + 4 * k;
            const u32x4 ov = *(const LAS u32x4*)(OW + (lane >> 2) * MX_P + ch * 8);
            *(u32x4*)(mixI + (size_t)(t0 + 16 * w + (lane >> 2)) * DM + TYPE * 1024 + h * 256 + 128 * half + ch * 8) = ov;
        }
        LDS_WAIT(); asm volatile("" ::: "memory");
    }
    __syncthreads();
}

struct MixArgs { const bf16_t* proj; const bf16_t* cq; const float* rowl; const float* coll; const float* wq; const float* wcol; const float* dec; bf16_t* mixI; bf16_t* mixE; float* denI; float* denE; };
__device__ __forceinline__ void phase_mixers(LAS unsigned char* lds, const MixArgs& A) {
    for (int item = blockIdx.x; item < 256; item += gridDim.x) {
        const int type = item & 1, rest = item >> 1, bh = rest >> 3, sl = rest & 7, b = bh >> 2, h = bh & 3;
        if (type == 0) inter_item<0>(lds, A.proj, A.cq, A.wq, A.wcol, A.dec, A.mixE, A.denE, b, h, sl);
        else inter_item<1>(lds, A.proj, A.cq, A.wq, A.wcol, A.dec, A.mixE, A.denE, b, h, sl);
    }
    { LAS bf16_t* VT = (LAS bf16_t*)(lds + IN_VT);
      for (int i = threadIdx.x; i < 16 * MX_P; i += 512) VT[256 * MX_P + i] = (i < MX_P) ? (bf16_t)0x3F80 : (bf16_t)0;
      __syncthreads(); }
    for (int item = blockIdx.x; item < 1024; item += gridDim.x) {
        const int type = item & 1, rest = item >> 1, c = rest & 31, bh = rest >> 5, b = bh >> 2, h = bh & 3;
        if (type == 0) intra_item<0>(lds, A.proj, A.cq, A.rowl, A.coll, A.mixI, A.denI, b, h, c);
        else intra_item<1>(lds, A.proj, A.cq, A.rowl, A.coll, A.mixI, A.denI, b, h, c);
    }
}

constexpr int AT_KP = 72, AT_VP = 280, AT_PP = 168;
constexpr int AT_KS = 0, AT_VT = 256 * AT_KP * 2, AT_PW = AT_VT + 64 * AT_VP * 2, AT_BIAS = AT_PW + 8 * 16 * AT_PP * 2, AT_END = AT_BIAS + 8 * 128 * 4;
static_assert(AT_END <= LDS_BYTES, "attention LDS");

__device__ __forceinline__ void phase_attn(LAS unsigned char* lds, const bf16_t* qkv, const float* biasT, const float* sinks, bf16_t* cat) {
    const int tid = threadIdx.x, lane = tid & 63, w = __builtin_amdgcn_readfirstlane(tid >> 6), fr = lane & 15, fq = lane >> 4;
    LAS bf16_t* KS = (LAS bf16_t*)(lds + AT_KS); LAS bf16_t* VT = (LAS bf16_t*)(lds + AT_VT);
    LAS bf16_t* PW = (LAS bf16_t*)(lds + AT_PW) + w * 16 * AT_PP; LAS float* BS = (LAS float*)(lds + AT_BIAS);
    for (int item = blockIdx.x; item < 512; item += gridDim.x) {
        const int kvh = item & 3, n = (item >> 2) & 31, b = item >> 7;
        const int tok0 = b * SEQ_T + n * 128;
        const int hq = kvh * 8 + w;
        bf16x8 qf[8][2];
#pragma unroll
        for (int it = 0; it < 8; ++it) {
            const bf16_t* qp = qkv + (size_t)(tok0 + 16 * it + fr) * NQKV + hq * 64 + fq * 8;
            qf[it][0] = *(const bf16x8*)qp; qf[it][1] = *(const bf16x8*)(qp + 32);
        }
        float bval[9][4];
#pragma unroll
        for (int t = 0; t < 9; ++t)
#pragma unroll
            for (int jj = 0; jj < 4; ++jj) {
                const int dist = 128 + fq * 4 + jj - 16 * t - fr;
                bval[t][jj] = (dist >= 0 && dist < 128) ? biasT[hq * 128 + (dist & 127)] : -INFINITY;
            }
#pragma unroll
        for (int k = 0; k < 4; ++k) {
            const int j = (tid >> 3) + 64 * k, cv = tid & 7;
            const int pos = n * 128 - 128 + j;
            u32x4 kk = {0u, 0u, 0u, 0u}, vv = {0u, 0u, 0u, 0u};
            if (pos >= 0) {
                const bf16_t* rp = qkv + (size_t)(b * SEQ_T + pos) * NQKV + kvh * 64 + cv * 8;
                kk = *(const u32x4*)(rp + 2048); vv = *(const u32x4*)(rp + 2304);
            }
            *(LAS u32x4*)(KS + j * AT_KP + cv * 8) = kk;
            const unsigned uu[4] = {vv.x, vv.y, vv.z, vv.w};
#pragma unroll
            for (int q = 0; q < 4; ++q) { VT[(cv * 8 + 2 * q) * AT_VP + j] = (bf16_t)(uu[q] & 0xffffu); VT[(cv * 8 + 2 * q + 1) * AT_VP + j] = (bf16_t)(uu[q] >> 16); }
        }
        for (int i = tid; i < 64 * 16; i += 512) VT[(i >> 4) * AT_VP + 256 + (i & 15)] = 0;
        __syncthreads();
        const float sink = sinks[hq];
#pragma unroll
        for (int it = 0; it < 8; ++it) {
            const bf16x8 q0 = qf[it][0], q1 = qf[it][1];
            f32x4 S[9];
#pragma unroll
            for (int t = 0; t < 9; ++t) {
                S[t] = (f32x4){0.f, 0.f, 0.f, 0.f};
                const LAS bf16_t* kp = KS + (16 * (it + t) + fr) * AT_KP + fq * 8;
                S[t] = MFMA16(q0, *(const LAS bf16x8*)kp, S[t]);
                S[t] = MFMA16(q1, *(const LAS bf16x8*)(kp + 32), S[t]);
            }
            float mx[4], sm[4];
#pragma unroll
            for (int jj = 0; jj < 4; ++jj) mx[jj] = -INFINITY;
#pragma unroll
            for (int t = 0; t < 9; ++t) {
                const bool cut = (n == 0) && (it + t < 8);
#pragma unroll
                for (int jj = 0; jj < 4; ++jj) {
                    float sv = fmaf(S[t][jj], 0.125f, bval[t][jj]);
                    if (cut) sv = -INFINITY;
                    S[t][jj] = sv; mx[jj] = fmaxf(mx[jj], sv);
                }
            }
#pragma unroll
            for (int jj = 0; jj < 4; ++jj) mx[jj] = fmaxf(row_max16(mx[jj]), sink);
#pragma unroll
            for (int jj = 0; jj < 4; ++jj) sm[jj] = 0.f;
#pragma unroll
            for (int t = 0; t < 9; ++t)
#pragma unroll
                for (int jj = 0; jj < 4; ++jj) { const float pv = __expf(S[t][jj] - mx[jj]); S[t][jj] = pv; sm[jj] += pv; }
#pragma unroll
            for (int jj = 0; jj < 4; ++jj) sm[jj] = row_sum16(sm[jj]) + __expf(sink - mx[jj]);
#pragma unroll
            for (int jj = 0; jj < 4; ++jj) {
#pragma unroll
                for (int t = 0; t < 9; ++t) PW[(fq * 4 + jj) * AT_PP + 16 * t + fr] = (bf16_t)f2bf(S[t][jj]);
                PW[(fq * 4 + jj) * AT_PP + 144 + fr] = 0;
            }
            LDS_WAIT(); asm volatile("" ::: "memory");
            f32x4 O[4];
#pragma unroll
            for (int e = 0; e < 4; ++e) O[e] = (f32x4){0.f, 0.f, 0.f, 0.f};
#pragma unroll
            for (int ks = 0; ks < 5; ++ks) {
                const bf16x8 af = *(const LAS bf16x8*)(PW + fr * AT_PP + ks * 32 + fq * 8);
#pragma unroll
                for (int e = 0; e < 4; ++e) { const bf16x8 bfr = *(const LAS bf16x8*)(VT + (16 * e + fr) * AT_VP + 16 * it + ks * 32 + fq * 8); O[e] = MFMA16(af, bfr, O[e]); }
            }
            LDS_WAIT(); asm volatile("" ::: "memory");
#pragma unroll
            for (int jj = 0; jj < 4; ++jj) {
                const float inv = 1.0f / sm[jj];
#pragma unroll
                for (int e = 0; e < 4; ++e) PW[(fq * 4 + jj) * AT_PP + 16 * e + fr] = (bf16_t)f2bf(O[e][jj] * inv);
            }
            LDS_WAIT(); asm volatile("" ::: "memory");
#pragma unroll
            for (int k = 0; k < 2; ++k) {
                const int ch = (lane & 3) + 4 * k;
                const u32x4 ov = *(const LAS u32x4*)(PW + (lane >> 2) * AT_PP + ch * 8);
                *(u32x4*)(cat + (size_t)(tok0 + 16 * it + (lane >> 2)) * DM + hq * 64 + ch * 8) = ov;
            }
            LDS_WAIT(); asm volatile("" ::: "memory");
        }
        __syncthreads();
    }
}

#define XB_TMO      128
#define XB_XCNT(j)  (256  + 64 * (j))
#define XB_XSUB(j)  (1280 + 64 * (j))
#define XB_XGEN(j)  (2304 + 64 * (j))
#define XB_TOP      3328
#define XB_TOPGEN   3392
#define XCD_BAR_WORDS 3456
#define XB_SPIN_CAP (1u << 22)
__device__ __forceinline__ unsigned xb_ld(unsigned* p)              { return __hip_atomic_load(p, __ATOMIC_RELAXED, __HIP_MEMORY_SCOPE_AGENT); }
__device__ __forceinline__ unsigned xb_add(unsigned* p, unsigned v) { return __hip_atomic_fetch_add(p, v, __ATOMIC_RELAXED, __HIP_MEMORY_SCOPE_AGENT); }
__device__ __forceinline__ unsigned xb_xcc_id() { return (unsigned)__builtin_amdgcn_s_getreg((3 << 11) | 20) & 0xFu; }
#define XB_SPIN(cond, bar) do { unsigned _sp = 0; while (cond) { __builtin_amdgcn_s_sleep(1); \
    if ((++_sp & 255u) == 0u) { if (xb_ld(&(bar)[XB_TMO])) break; if (_sp > XB_SPIN_CAP) { atomicAdd(&(bar)[XB_TMO], 1u); break; } } } } while (0)
struct XcdBarrier { unsigned* bar; unsigned x; volatile LAS unsigned* st; };
__device__ __forceinline__ XcdBarrier xcd_barrier_post(unsigned* bar, volatile LAS unsigned* st) {
    XcdBarrier b; b.bar = bar; b.x = xb_xcc_id(); b.st = st;
    if (threadIdx.x == 0) (void)xb_add(&bar[XB_XCNT(b.x)], 1u);
    return b;
}
__device__ __forceinline__ void xcd_barrier_complete(unsigned* bar, unsigned x, unsigned& nloc, unsigned& nx) {
    const unsigned G = gridDim.x * gridDim.y * gridDim.z;
    unsigned sum, cnt, mine, sp = 0u;
    for (;;) {
        sum = 0u; cnt = 0u; mine = 0u;
#pragma unroll
        for (unsigned j = 0; j < 16; ++j) { const unsigned c = xb_ld(&bar[XB_XCNT(j)]); sum += c; cnt += (c > 0u) ? 1u : 0u; mine = (j == x) ? c : mine; }
        if (sum == G) break;
        __builtin_amdgcn_s_sleep(1);
        if ((++sp & 255u) == 0u) { if (xb_ld(&bar[XB_TMO])) break; if (sp > XB_SPIN_CAP) { atomicAdd(&bar[XB_TMO], 1u); break; } }
    }
    nloc = mine > 0u ? mine : 1u; nx = cnt > 0u ? cnt : 1u;
}
__device__ __forceinline__ void xcd_barrier(const XcdBarrier& b) {
    asm volatile("s_waitcnt vmcnt(0)" ::: "memory");
    __syncthreads();
    if (threadIdx.x == 0) {
        unsigned* bar = b.bar;
        __builtin_amdgcn_s_waitcnt(0);
        unsigned nloc = b.st[0], nx = b.st[1];
        if (nloc == 0u) { xcd_barrier_complete(bar, b.x, nloc, nx); b.st[0] = nloc; b.st[1] = nx; }
        const unsigned old = xb_add(&bar[XB_XSUB(b.x)], 1u);
        const unsigned gen = old / nloc;
        if (old + 1u == (gen + 1u) * nloc) {
            __builtin_amdgcn_fence(__ATOMIC_RELEASE, "agent");
            asm volatile("s_waitcnt vmcnt(0)" ::: "memory");
            const unsigned og = xb_add(&bar[XB_TOP], 1u);
            const unsigned tg = og / nx;
            if (og + 1u == (tg + 1u) * nx) xb_add(&bar[XB_TOPGEN], 1u);
            else XB_SPIN(xb_ld(&bar[XB_TOPGEN]) == tg, bar);
            __builtin_amdgcn_fence(__ATOMIC_ACQUIRE, "agent");
            xb_add(&bar[XB_XGEN(b.x)], 1u);
            asm volatile("s_waitcnt vmcnt(0)" ::: "memory");
        } else {
            XB_SPIN(xb_ld(&bar[XB_XGEN(b.x)]) == gen, bar);
            __builtin_amdgcn_fence(__ATOMIC_ACQUIRE, "agent");
            asm volatile("s_waitcnt vmcnt(0)" ::: "memory");
        }
    }
    __syncthreads();
}

__global__ void __launch_bounds__(512, 2) fwd_kernel(Args args) {
    extern __shared__ __attribute__((aligned(16))) unsigned char lds_raw[];
    LAS unsigned char* lds = (LAS unsigned char*)lds_raw;
    cg::grid_group grid = cg::this_grid();
    unsigned char* ws = args.ws;
    const int lo = args.ph_lo, hi = args.ph_hi;
#define IN(k) (lo <= (k) && (k) < hi)
    volatile LAS unsigned* bst = (volatile LAS unsigned*)(lds + LDS_BYTES - 64);
    if (threadIdx.x < 2) bst[threadIdx.x] = 0u;
    __syncthreads();
    const XcdBarrier xbar = xcd_barrier_post((unsigned*)(ws + OFF_CTL), bst);
#define SEAM(k) do { if (IN(k) && IN((k) + 1)) { if ((k) == 0) grid.sync(); else xcd_barrier(xbar); } } while (0)
    const float* x = args.in[0];
    const float* norm_g = args.in[2];
    float* out = args.out;
    bf16_t* bufA = (bf16_t*)(ws + OFF_A);
    float* bufY = (float*)(ws + OFF_Y);
    bf16_t* bufH = (bf16_t*)(ws + OFF_H);
    const int G = gridDim.x, cidx = blockIdx.x;

    if (IN(0)) phase_prologue(lds, args);
    SEAM(0);
    if (IN(1)) {
        pg8::Gemm g{bufH, (const bf16_t*)(ws + OFF_WIN), M_TOK, NPROJ, DM}; pg8::StaticOrder S; S.init(M_TOK, NPROJ, G, cidx);
        EpiProj0 E{bufA, (const float*)(ws + OFF_COS), (const float*)(ws + OFF_SIN)};
        pg8::gemm_phase<EpiProj0, pg8::StaticOrder, true, true>(lds, g, S, E);
    }
    SEAM(1);
    const GateArrays GA{(float*)(ws + OFF_GA_ROWL), (float*)(ws + OFF_GA_COLL), (float*)(ws + OFF_GA_WQ), (float*)(ws + OFF_GA_WCOL), (float*)(ws + OFF_GA_FLR), (float*)(ws + OFF_GA_DEC)};
    bf16_t* mixI = (bf16_t*)bufY; bf16_t* mixE = (bf16_t*)bufY + (size_t)M_TOK * DM;
    bf16_t* xs = mixE;
    if (IN(2)) {
        phase_conv(bufA, args.in[6], bufH, (const float*)(ws + OFF_GATES), GA);
        xcd_barrier(xbar);
        const MixArgs MA{bufA, bufH, GA.rowl, GA.coll, GA.wq, GA.wcol, GA.dec, mixI, mixE, (float*)(ws + OFF_DENI), (float*)(ws + OFF_DENE)};
        phase_mixers(lds, MA);
    }
    SEAM(2);
    if (IN(3)) phase_combine(mixI, mixE, (const float*)(ws + OFF_DENI), (const float*)(ws + OFF_DENE), GA.flr, bufA, args.in[8], bufH);
    SEAM(3);
    if (IN(4)) {
        pg8::Gemm g{bufH, (const bf16_t*)(ws + OFF_WOUT0), M_TOK, DM, DM}; pg8::StaticOrder S; S.init(M_TOK, DM, G, cidx);
        EpiBf16 E{(bf16_t*)bufY, DM};
        pg8::gemm_phase<EpiBf16, pg8::StaticOrder, true, true>(lds, g, S, E);
    }
    SEAM(4);
    if (IN(5)) phase_normres<false, true>(x, xs, (const bf16_t*)bufY, norm_g + 1 * DM, norm_g + 2 * DM, bufH);
    SEAM(5);
    if (IN(6)) {
        pg8::Gemm g{bufH, (const bf16_t*)(ws + OFF_WGU0), M_TOK, 2 * FF, DM}; pg8::StaticOrder S; S.init(M_TOK, 2 * FF, G, cidx);
        EpiSwiGLU E{bufA};
        pg8::gemm_phase<EpiSwiGLU, pg8::StaticOrder, true, true>(lds, g, S, E);
    }
    SEAM(6);
    if (IN(7)) {
        pg8::Gemm g{bufA, (const bf16_t*)(ws + OFF_WD0), M_TOK, DM, FF}; pg8::StaticOrder S; S.init(M_TOK, DM, G, cidx);
        EpiBf16 E{(bf16_t*)bufY, DM};
        pg8::gemm_phase<EpiBf16, pg8::StaticOrder, true, true>(lds, g, S, E);
    }
    SEAM(7);
    if (IN(8)) phase_normres<true, true>(xs, xs, (const bf16_t*)bufY, norm_g + 3 * DM, norm_g + 4 * DM, bufH);
    SEAM(8);
    if (IN(9)) {
        pg8::Gemm g{bufH, (const bf16_t*)(ws + OFF_WSWA), M_TOK, NQKV, DM}; pg8::StaticOrder S; S.init(M_TOK, NQKV, G, cidx);
        EpiBf16 E{bufA, NQKV};
        pg8::gemm_phase<EpiBf16, pg8::StaticOrder, true, true>(lds, g, S, E);
    }
    SEAM(9);
    if (IN(10)) phase_attn(lds, bufA, (const float*)(ws + OFF_BIAS), args.in[11], bufH);
    SEAM(10);
    if (IN(11)) {
        pg8::Gemm g{bufH, (const bf16_t*)(ws + OFF_WO1), M_TOK, DM, DM}; pg8::StaticOrder S; S.init(M_TOK, DM, G, cidx);
        EpiBf16 E{(bf16_t*)bufY, DM};
        pg8::gemm_phase<EpiBf16, pg8::StaticOrder, true, true>(lds, g, S, E);
    }
    SEAM(11);
    if (IN(12)) phase_normres<true, true>(xs, xs, (const bf16_t*)bufY, norm_g + 5 * DM, norm_g + 6 * DM, bufH);
    SEAM(12);
    if (IN(13)) {
        pg8::Gemm g{bufH, (const bf16_t*)(ws + OFF_WGU1), M_TOK, 2 * FF, DM}; pg8::StaticOrder S; S.init(M_TOK, 2 * FF, G, cidx);
        EpiSwiGLU E{bufA};
        pg8::gemm_phase<EpiSwiGLU, pg8::StaticOrder, true, true>(lds, g, S, E);
    }
    SEAM(13);
    if (IN(14)) {
        pg8::Gemm g{bufA, (const bf16_t*)(ws + OFF_WD1), M_TOK, DM, FF}; pg8::StaticOrder S; S.init(M_TOK, DM, G, cidx);
        EpiBf16 E{(bf16_t*)bufY, DM};
        pg8::gemm_phase<EpiBf16, pg8::StaticOrder, true, true>(lds, g, S, E);
    }
    SEAM(14);
    if (IN(15)) phase_normres<true, false>(xs, out, (const bf16_t*)bufY, norm_g + 7 * DM, nullptr, bufH);
}

extern "C" void kernel_launch(void* const* d_in, const int* in_sizes, int n_in, void* d_out, int out_size, void* d_ws, size_t ws_size, hipStream_t stream) {
    static int grid = 0;
    if (grid == 0) {
        if (n_in != 13 || ws_size < WS_END) { fprintf(stderr, "kernel_launch: unexpected n_in %d / ws %zu (need %zu)\n", n_in, ws_size, (size_t)WS_END); grid = -1; return; }
        int dev = 0, cus = 0, per_cu = 0;
        hipGetDevice(&dev);
        hipDeviceGetAttribute(&cus, hipDeviceAttributeMultiprocessorCount, dev);
        if (hipFuncSetAttribute((const void*)fwd_kernel, hipFuncAttributeMaxDynamicSharedMemorySize, LDS_BYTES) != hipSuccess) { fprintf(stderr, "kernel_launch: hipFuncSetAttribute failed\n"); grid = -1; return; }
        if (hipOccupancyMaxActiveBlocksPerMultiprocessor(&per_cu, (const void*)fwd_kernel, 512, LDS_BYTES) != hipSuccess || per_cu < 1) { fprintf(stderr, "kernel_launch: occupancy query says %d\n", per_cu); per_cu = 1; }
        (void)hipGetLastError();
        grid = cus * per_cu;
    }
    if (grid < 0) return;
    if (hipMemsetAsync((char*)d_ws + OFF_CTL, 0, CTL_BYTES, stream) != hipSuccess) { fprintf(stderr, "kernel_launch: memset of barrier words failed\n"); return; }
    Args a{};
    for (int i = 0; i < 13; ++i) a.in[i] = (const float*)d_in[i];
    a.out = (float*)d_out; a.ws = (unsigned char*)d_ws; a.ph_lo = 0; a.ph_hi = 16;
    void* kargs[] = {&a};
    hipError_t e = hipLaunchCooperativeKernel((const void*)fwd_kernel, dim3(grid), dim3(512), kargs, LDS_BYTES, stream);
    if (e != hipSuccess) fprintf(stderr, "cooperative launch failed: %s (grid %d)\n", hipGetErrorString(e), grid);
}
```
